# Optimizing an MI355X kernel written in HIP

```python
import math
import jax, jax.numpy as jnp
from jax import lax
import numpy as np

D_MODEL = 1024
BATCH = 8
SEQ = 2048
DEPTH = 1

SSD_EXPAND = 2
SSD_D_INNER = SSD_EXPAND * D_MODEL
SSD_HEAD_DIM = 64
SSD_HEADS = SSD_D_INNER // SSD_HEAD_DIM
SSD_GROUPS = 4
SSD_HEADS_PER_GROUP = SSD_HEADS // SSD_GROUPS
SSD_STATE = 128
SSD_CONV = 4
SSD_CHUNK = 128
SSD_CONV_CH = SSD_D_INNER + 2 * SSD_GROUPS * SSD_STATE
SSD_DT_MIN = 0.001
SSD_DT_MAX = 0.1

DA_HEAD_DIM = 64
DA_HEADS = D_MODEL // (2 * DA_HEAD_DIM)
DA_V_DIM = 2 * DA_HEAD_DIM
DA_WIDTH = DA_HEADS * 2 * DA_HEAD_DIM
Q_BLOCK = 128

N_BRANCH = 2
D_FF = 2816
EPS = 1e-6

IN_SIZES = [SSD_D_INNER, SSD_CONV_CH, SSD_HEADS, DA_WIDTH, DA_WIDTH, DA_WIDTH, N_BRANCH * D_MODEL]
D_IN_PROJ = sum(IN_SIZES)
IN_SPLITS = np.cumsum(IN_SIZES)[:-1].tolist()

kernel_name = "hybrid_ssd_diffattn_macaron_block"


def rmsnorm(x, g):
    xf = x.astype(jnp.float32)
    y = xf * lax.rsqrt(jnp.mean(xf * xf, axis=-1, keepdims=True) + EPS)
    return y.astype(x.dtype) * g


def swiglu(x, w_gate, w_up, w_down):
    return (jax.nn.silu(x @ w_gate) * (x @ w_up)) @ w_down


def alibi_slopes(n_heads):
    return jnp.asarray(2.0 ** (-8.0 * np.arange(1, n_heads + 1) / n_heads), dtype=jnp.float32)


def causal_dwconv(x, w, b):
    k = w.shape[0]
    y = lax.conv_general_dilated(x, w[:, None, :], window_strides=(1,), padding=[(k - 1, 0)],
                                 dimension_numbers=("NWC", "WIO", "NWC"),
                                 feature_group_count=x.shape[-1])
    return y + b


def ssd_chunked(x, dt, a_head, bm, cm):
    b, L, H, P = x.shape
    G, N, E, Q = SSD_GROUPS, SSD_STATE, SSD_HEADS_PER_GROUP, SSD_CHUNK
    nc = L // Q
    X = (x.astype(jnp.float32) * dt[..., None]).reshape(b, nc, Q, G, E, P)
    a = (dt * a_head).reshape(b, nc, Q, G, E).transpose(0, 3, 4, 1, 2)
    Bc = bm.astype(jnp.float32).reshape(b, nc, Q, G, N)
    Cc = cm.astype(jnp.float32).reshape(b, nc, Q, G, N)
    a_cum = jnp.cumsum(a, axis=-1)
    seg = a_cum[..., :, None] - a_cum[..., None, :]
    causal = jnp.tril(jnp.ones((Q, Q), dtype=bool))
    Lmat = jnp.exp(jnp.where(causal, seg, -jnp.inf))
    CB = jnp.einsum('bclgn,bcsgn->bgcls', Cc, Bc)
    y_diag = jnp.einsum('bgcls,bgecls,bcsgep->bclgep', CB, Lmat, X)
    decay_states = jnp.exp(a_cum[..., -1:] - a_cum)
    states = jnp.einsum('bclgn,bgecl,bclgep->bcgepn', Bc, decay_states, X)
    chunk_decay = jnp.exp(a_cum[..., -1])

    def step(h, inp):
        s, d = inp
        return h * d[..., None, None] + s, h

    _, prev = lax.scan(step, jnp.zeros(states.shape[:1] + states.shape[2:], jnp.float32),
                       (jnp.moveaxis(states, 1, 0), jnp.moveaxis(chunk_decay, 3, 0)))
    prev = jnp.moveaxis(prev, 0, 1)
    y_off = jnp.einsum('bclgn,bcgepn,bgecl->bclgep', Cc, prev, jnp.exp(a_cum))
    return (y_diag + y_off).reshape(b, L, H, P)


def ssd_branch(z, xbc, dt_raw, conv_w, conv_b, dt_bias, a_log, d_skip, norm_g, w_branch):
    b, L, _ = z.shape
    xbc = jax.nn.silu(causal_dwconv(xbc, conv_w, conv_b))
    xs, bm, cm = jnp.split(xbc, [SSD_D_INNER, SSD_D_INNER + SSD_GROUPS * SSD_STATE], axis=-1)
    dt = jax.nn.softplus(dt_raw.astype(jnp.float32) + dt_bias.astype(jnp.float32))
    a_head = -jnp.exp(a_log.astype(jnp.float32))
    xh = xs.reshape(b, L, SSD_HEADS, SSD_HEAD_DIM)
    y = ssd_chunked(xh, dt, a_head,
                    bm.reshape(b, L, SSD_GROUPS, SSD_STATE), cm.reshape(b, L, SSD_GROUPS, SSD_STATE))
    y = (y + d_skip.astype(jnp.float32)[:, None] * xh.astype(jnp.float32)).astype(z.dtype)
    y = y.reshape(b, L, SSD_D_INNER) * jax.nn.silu(z)
    y = rmsnorm(y.reshape(b, L, SSD_GROUPS, SSD_D_INNER // SSD_GROUPS), 1.0).reshape(b, L, SSD_D_INNER) * norm_g
    return y @ w_branch


def diff_attn_branch(q, k, v, lq1, lk1, lq2, lk2, subln_g, w_branch, lam_init):
    b, L, _ = q.shape
    H, d = DA_HEADS, DA_HEAD_DIM
    q = q.reshape(b, L, H, 2, d)
    k = k.reshape(b, L, H, 2, d)
    v = v.reshape(b, L, H, DA_V_DIM)
    lam = (jnp.exp(jnp.sum(lq1.astype(jnp.float32) * lk1.astype(jnp.float32)))
           - jnp.exp(jnp.sum(lq2.astype(jnp.float32) * lk2.astype(jnp.float32))) + lam_init)
    slopes = alibi_slopes(H)
    scale = 1.0 / math.sqrt(d)
    nb = L // Q_BLOCK
    qb = q.reshape(b, nb, Q_BLOCK, H, 2, d).transpose(1, 0, 2, 3, 4, 5)
    key_pos = jnp.arange(L)

    def one_block(args):
        q_blk, i = args
        q_pos = i * Q_BLOCK + jnp.arange(Q_BLOCK)
        s = jnp.einsum('bqhmd,bkhmd->bhmqk', q_blk, k).astype(jnp.float32) * scale
        dist = (q_pos[:, None] - key_pos[None, :]).astype(jnp.float32)
        s = s - slopes[None, :, None, None, None] * dist
        s = jnp.where(dist >= 0, s, -jnp.inf)
        p = jax.nn.softmax(s, axis=-1)
        attn = p[:, :, 0] - lam * p[:, :, 1]
        return jnp.einsum('bhqk,bkhe->bqhe', attn.astype(v.dtype), v)

    out = lax.map(one_block, (qb, jnp.arange(nb)))
    out = out.transpose(1, 0, 2, 3, 4).reshape(b, L, H, DA_V_DIM)
    out = rmsnorm(out, subln_g) * (1.0 - lam_init)
    return out.reshape(b, L, DA_WIDTH) @ w_branch


def setup_inputs(seed: int = 0) -> dict:
    key = jax.random.key(seed)
    ks = iter(jax.random.split(key, 40))
    f32 = jnp.float32

    def nrm(shape, fan_in):
        return jax.random.normal(next(ks), (DEPTH,) + shape, f32) * fan_in ** -0.5

    def gain(n):
        return 1.0 + 0.05 * jax.random.normal(next(ks), (DEPTH, n), f32)

    x = jax.random.normal(next(ks), (BATCH, SEQ, D_MODEL), f32)
    dt0 = jnp.exp(jax.random.uniform(next(ks), (DEPTH, SSD_HEADS), f32)
                  * (math.log(SSD_DT_MAX) - math.log(SSD_DT_MIN)) + math.log(SSD_DT_MIN))
    dt0 = jnp.maximum(dt0, 1e-4)
    return {
        "x": x,
        "ffn1_pre_g": gain(D_MODEL),
        "ffn1_w_gate": nrm((D_MODEL, D_FF), D_MODEL),
        "ffn1_w_up": nrm((D_MODEL, D_FF), D_MODEL),
        "ffn1_w_down": nrm((D_FF, D_MODEL), D_FF),
        "ffn1_post_g": gain(D_MODEL),
        "mix_pre_g": gain(D_MODEL),
        "w_in": nrm((D_MODEL, D_IN_PROJ), D_MODEL),
        "gate_b": 0.02 * jax.random.normal(next(ks), (DEPTH, N_BRANCH * D_MODEL), f32),
        "ssd_conv_w": nrm((SSD_CONV, SSD_CONV_CH), SSD_CONV),
        "ssd_conv_b": 0.02 * jax.random.normal(next(ks), (DEPTH, SSD_CONV_CH), f32),
        "ssd_dt_bias": dt0 + jnp.log(-jnp.expm1(-dt0)),
        "ssd_A_log": jnp.log(jax.random.uniform(next(ks), (DEPTH, SSD_HEADS), f32, 1.0, 16.0)),
        "ssd_D": gain(SSD_HEADS),
        "ssd_norm_g": gain(SSD_D_INNER),
        "ssd_w_branch": nrm((SSD_D_INNER, D_MODEL), SSD_D_INNER),
        "da_lambda_q1": 0.1 * jax.random.normal(next(ks), (DEPTH, DA_HEAD_DIM), f32),
        "da_lambda_k1": 0.1 * jax.random.normal(next(ks), (DEPTH, DA_HEAD_DIM), f32),
        "da_lambda_q2": 0.1 * jax.random.normal(next(ks), (DEPTH, DA_HEAD_DIM), f32),
        "da_lambda_k2": 0.1 * jax.random.normal(next(ks), (DEPTH, DA_HEAD_DIM), f32),
        "da_subln_g": gain(DA_V_DIM),
        "da_w_branch": nrm((DA_WIDTH, D_MODEL), DA_WIDTH),
        "w_out": nrm((D_MODEL, D_MODEL), D_MODEL),
        "mix_post_g": gain(D_MODEL),
        "ffn2_pre_g": gain(D_MODEL),
        "ffn2_w_gate": nrm((D_MODEL, D_FF), D_MODEL),
        "ffn2_w_up": nrm((D_MODEL, D_FF), D_MODEL),
        "ffn2_w_down": nrm((D_FF, D_MODEL), D_FF),
        "ffn2_post_g": gain(D_MODEL),
    }


def reference(x, ffn1_pre_g, ffn1_w_gate, ffn1_w_up, ffn1_w_down, ffn1_post_g,
              mix_pre_g, w_in, gate_b,
              ssd_conv_w, ssd_conv_b, ssd_dt_bias, ssd_A_log, ssd_D, ssd_norm_g, ssd_w_branch,
              da_lambda_q1, da_lambda_k1, da_lambda_q2, da_lambda_k2, da_subln_g, da_w_branch,
              w_out, mix_post_g,
              ffn2_pre_g, ffn2_w_gate, ffn2_w_up, ffn2_w_down, ffn2_post_g):
    h = x
    b, L, _ = x.shape
    for l in range(DEPTH):
        lam_init = 0.8 - 0.6 * math.exp(-0.3 * l)
        h = h + 0.5 * rmsnorm(swiglu(rmsnorm(h, ffn1_pre_g[l]), ffn1_w_gate[l], ffn1_w_up[l], ffn1_w_down[l]),
                              ffn1_post_g[l])
        u = rmsnorm(h, mix_pre_g[l])
        z, xbc, dt_raw, q, k, v, gate_logits = jnp.split(u @ w_in[l], IN_SPLITS, axis=-1)
        y_ssd = ssd_branch(z, xbc, dt_raw, ssd_conv_w[l], ssd_conv_b[l], ssd_dt_bias[l], ssd_A_log[l],
                           ssd_D[l], ssd_norm_g[l], ssd_w_branch[l])
        y_att = diff_attn_branch(q, k, v, da_lambda_q1[l], da_lambda_k1[l], da_lambda_q2[l], da_lambda_k2[l],
                                 da_subln_g[l], da_w_branch[l], lam_init)
        gates = jax.nn.sigmoid(gate_logits + gate_b[l]).reshape(b, L, N_BRANCH, D_MODEL)
        merged = gates[:, :, 0] * y_ssd + gates[:, :, 1] * y_att
        h = h + rmsnorm(merged @ w_out[l], mix_post_g[l])
        h = h + 0.5 * rmsnorm(swiglu(rmsnorm(h, ffn2_pre_g[l]), ffn2_w_gate[l], ffn2_w_up[l], ffn2_w_down[l]),
                              ffn2_post_g[l])
    return h
```

```cpp
#include <hip/hip_runtime.h>
#include <cstdio>
#include <cstdint>
namespace pg8 {
#define PG8_LAS __attribute__((address_space(3)))
typedef unsigned short bf16_t;
typedef short bf16x8 __attribute__((ext_vector_type(8)));
typedef float f32x4 __attribute__((ext_vector_type(4)));
typedef unsigned u32x4 __attribute__((ext_vector_type(4)));
constexpr int BM = 256, BK = 64, HALF = 128, HTB = HALF * BK * 2  , STAGE_BYTES = 8 * HTB, NXCD = 8, WGM = 8;

__host__ __device__ __forceinline__ int lds_byte(int r, int c) { const int st = (r >> 4) * 2 + (c >> 5), rr = r & 15, cc = c & 31, ob = rr * 64 + cc * 2; return st * 1024 + (ob ^ (((ob >> 9) & 1) << 5)); }
__host__ __device__ __forceinline__ void stage_rc(int b, int& R, int& C) { const int st = b / 1024, sb = b % 1024, swz = sb ^ (((sb >> 9) & 1) << 5); R = (st >> 1) * 16 + swz / 64; C = (st & 1) * 32 + (swz % 64) / 2; }
__host__ __device__ __forceinline__ int perm32(int rho) { const int n = rho >> 4, i = rho & 15; return 8 * (i >> 2) + 4 * n + (i & 3); }

struct Unit { int pm, pn; };
struct Gemm { const bf16_t* A; const bf16_t* Bt; int M, N, K; };

struct StaticOrder {
    int nM, nN, nwg, G, c;
    __host__ __device__ void init(int M, int N, int G_, int c_) { nM = M / BM; nN = N / BM; nwg = nM * nN; G = G_; c = c_; }
    __host__ __device__ bool next(int i, Unit& u) const {
        const long L = (long)i * G + c; if (L >= nwg) return false;
        int wgid = (int)L; { const int q = nwg / NXCD, r = nwg % NXCD, xcd = wgid % NXCD, off = wgid / NXCD; wgid = (xcd < r ? xcd * (q + 1) : r * (q + 1) + (xcd - r) * q) + off; }
        const int nig = WGM * nN, gid = wgid / nig, fm = gid * WGM, gsz = (nM - fm) < WGM ? (nM - fm) : WGM;
        u.pm = fm + ((wgid % nig) % gsz); u.pn = (wgid % nig) / gsz; return true;
    }
    __device__ __forceinline__ void a_ready(const Unit&) const {}
    __device__ __forceinline__ void done(const Unit&) const {}
};

__device__ __forceinline__ unsigned cvt_pk_bf16(float lo, float hi) { unsigned r; asm volatile("v_cvt_pk_bf16_f32 %0, %1, %2" : "=v"(r) : "v"(lo), "v"(hi)); return r; }
typedef float f32x2 __attribute__((ext_vector_type(2)));
typedef unsigned u32x2 __attribute__((ext_vector_type(2)));
__device__ __forceinline__ float bf_lo(unsigned w) { return __uint_as_float(w << 16); }
__device__ __forceinline__ float bf_hi(unsigned w) { return __uint_as_float(w & 0xffff0000u); }
__device__ __forceinline__ float sigmoid_f(float x) { return __builtin_amdgcn_rcpf(1.0f + __builtin_amdgcn_exp2f(-1.4426950408889634f * x)); }
__device__ __forceinline__ float silu_f(float x) { return x * sigmoid_f(x); }
__device__ __forceinline__ u32x4 pack8(const f32x4 v0, const f32x4 v1) { u32x4 w; w.x = cvt_pk_bf16(v0[0], v0[1]); w.y = cvt_pk_bf16(v0[2], v0[3]); w.z = cvt_pk_bf16(v1[0], v1[1]); w.w = cvt_pk_bf16(v1[2], v1[3]); return w; }

struct EpiF32 {
    static constexpr bool PERM = false, AFTER_DRAIN = false;
    float* C; int ldc;
    __device__ __forceinline__ void operator()(const f32x4 (&acc)[2][2][4][2], const Unit& u, int wr, int wc, int fr, int fq) const {
        const int row0 = u.pm * BM + wr * 64 + fr, col0 = u.pn * BM + wc * 32 + 4 * fq;
#pragma unroll
        for (int ai = 0; ai < 2; ++ai)
#pragma unroll
            for (int m = 0; m < 4; ++m) { float* rowp = C + (size_t)(row0 + ai * HALF + m * 16) * ldc + col0;
#pragma unroll
                for (int bj = 0; bj < 2; ++bj)
#pragma unroll
                    for (int n = 0; n < 2; ++n) *(f32x4*)(rowp + bj * HALF + n * 16) = acc[ai][bj][m][n]; }
    }
};
struct EpiSwiGLU {
    static constexpr bool PERM = true, AFTER_DRAIN = false;
    bf16_t* O; int ldc;
    __device__ __forceinline__ void operator()(const f32x4 (&acc)[2][2][4][2], const Unit& u, int wr, int wc, int fr, int fq) const {
        const int row0 = u.pm * BM + wr * 64 + fr, col0 = u.pn * HALF + wc * 32 + 8 * fq;
#pragma unroll
        for (int ai = 0; ai < 2; ++ai)
#pragma unroll
            for (int m = 0; m < 4; ++m) { bf16_t* rowp = O + (size_t)(row0 + ai * HALF + m * 16) * ldc + col0;
                f32x4 v0, v1;
#pragma unroll
                for (int j = 0; j < 4; ++j) { v0[j] = silu_f(acc[ai][0][m][0][j]) * acc[ai][1][m][0][j]; v1[j] = silu_f(acc[ai][0][m][1][j]) * acc[ai][1][m][1][j]; }
                *(u32x4*)rowp = pack8(v0, v1); }
    }
};
template <class Op> struct EpiRow8 {
    static constexpr bool PERM = true, AFTER_DRAIN = false;
    Op op;
    __device__ __forceinline__ void operator()(const f32x4 (&acc)[2][2][4][2], const Unit& u, int wr, int wc, int fr, int fq) const {
        const int row0 = u.pm * BM + wr * 64 + fr, tc0 = wc * 32 + 8 * fq;
#pragma unroll
        for (int ai = 0; ai < 2; ++ai)
#pragma unroll
            for (int m = 0; m < 4; ++m)
#pragma unroll
                for (int bj = 0; bj < 2; ++bj) op.st(row0 + ai * HALF + m * 16, tc0 + bj * HALF, u, acc[ai][bj][m][0], acc[ai][bj][m][1]);
    }
};
struct OpQKV { bf16_t* Q; size_t stride; float qscale;
    __device__ __forceinline__ void st(int row, int tc, const Unit& u, f32x4 v0, f32x4 v1) const {
        const int t = u.pn >> 2, col = (u.pn & 3) * BM + tc; const float sc = (t == 0) ? qscale : 1.0f;
        *(u32x4*)(Q + (size_t)t * stride + (size_t)row * 1024 + col) = pack8(v0 * sc, v1 * sc); } };
struct OpZX { bf16_t* Z; bf16_t* XBC;
    __device__ __forceinline__ void st(int row, int tc, const Unit& u, f32x4 v0, f32x4 v1) const {
        if (u.pn < 8) {
#pragma unroll
            for (int j = 0; j < 4; ++j) { v0[j] = silu_f(v0[j]); v1[j] = silu_f(v1[j]); }
            *(u32x4*)(Z + (size_t)row * 2048 + u.pn * BM + tc) = pack8(v0, v1);
        } else *(u32x4*)(XBC + (size_t)row * 3072 + (u.pn - 8) * BM + tc) = pack8(v0, v1); } };
struct OpGate { bf16_t* G; const float* bias;
    __device__ __forceinline__ void st(int row, int tc, const Unit& u, f32x4 v0, f32x4 v1) const {
        const int col = u.pn * BM + tc; const f32x4 b0 = *(const f32x4*)(bias + col), b1 = *(const f32x4*)(bias + col + 4);
#pragma unroll
        for (int j = 0; j < 4; ++j) { v0[j] = sigmoid_f(v0[j] + b0[j]); v1[j] = sigmoid_f(v1[j] + b1[j]); }
        *(u32x4*)(G + (size_t)row * 2048 + col) = pack8(v0, v1); } };
template <bool FIRST> struct OpMerge { bf16_t* Mg; const bf16_t* G;
    __device__ __forceinline__ void st(int row, int tc, const Unit& u, f32x4 v0, f32x4 v1) const {
        const int col = u.pn * BM + tc; const u32x4 g = *(const u32x4*)(G + (size_t)row * 2048 + (FIRST ? 0 : 1024) + col);
        v0[0] *= bf_lo(g.x); v0[1] *= bf_hi(g.x); v0[2] *= bf_lo(g.y); v0[3] *= bf_hi(g.y); v1[0] *= bf_lo(g.z); v1[1] *= bf_hi(g.z); v1[2] *= bf_lo(g.w); v1[3] *= bf_hi(g.w);
        bf16_t* p = Mg + (size_t)row * 1024 + col;
        if (!FIRST) { const u32x4 o = *(const u32x4*)p;
            v0[0] += bf_lo(o.x); v0[1] += bf_hi(o.x); v0[2] += bf_lo(o.y); v0[3] += bf_hi(o.y); v1[0] += bf_lo(o.z); v1[1] += bf_hi(o.z); v1[2] += bf_lo(o.w); v1[3] += bf_hi(o.w); }
        *(u32x4*)p = pack8(v0, v1); } };
template <class Epi, class Sched, bool ALIGN_EPI = false, bool SP2 = false>
__device__ __forceinline__ void gemm_phase(PG8_LAS unsigned char* lds, const Gemm g, const Sched& S, const Epi& E) {
    const int tid = threadIdx.x, wid = __builtin_amdgcn_readfirstlane(tid >> 6), lane = tid & 63, wr = wid >> 2, wc = wid & 3, fr = lane & 15, fq = lane >> 4;
    const int K = g.K, nt = K / BK;
    unsigned voffA[2], voffB[2];
#pragma unroll
    for (int i = 0; i < 2; ++i) { int R, C; stage_rc(tid * 16 + i * 8192, R, C); const int Rb = Epi::PERM ? ((R & ~31) + perm32(R & 31)) : R;
        voffA[i] = (unsigned)(R * K + C) * 2u; voffB[i] = (unsigned)(Rb * K + C) * 2u; }
    const size_t kstep = (size_t)(BK * 2);
    const size_t hstep = (size_t)HALF * K * 2;
    const size_t tstep = 2 * hstep;
    const unsigned ldsw = (unsigned)wid * 1024u;
    const int aoff = lds_byte(wr * 64 + fr, fq * 8), boff = lds_byte(wc * 32 + fr, fq * 8);
#define PG8_SA(b, h) (((b) * 2 + (h)) * HTB)
#define PG8_SB(b, h) ((4 + (b) * 2 + (h)) * HTB)
#define PG8_STAGE(bufoff, gbase, voff) do { _Pragma("unroll") for (int _i = 0; _i < 2; ++_i) \
        __builtin_amdgcn_global_load_lds((const unsigned*)((const char*)(gbase) + (voff)[_i]), (PG8_LAS unsigned*)(lds + (bufoff) + ldsw + _i * 8192), 16, 0, 0); } while (0)
#define PG8_LDA(dst, b, h) do { _Pragma("unroll") for (int m = 0; m < 4; ++m) _Pragma("unroll") for (int k = 0; k < 2; ++k) dst[m][k] = *(const PG8_LAS bf16x8*)(lds + PG8_SA(b, h) + aoff + m * 2048 + k * 1024); } while (0)
#define PG8_LDB(dst, b, h) do { _Pragma("unroll") for (int n = 0; n < 2; ++n) _Pragma("unroll") for (int k = 0; k < 2; ++k) dst[n][k] = *(const PG8_LAS bf16x8*)(lds + PG8_SB(b, h) + boff + n * 2048 + k * 1024); } while (0)
#define PG8_MMA(ai, bj, At, Bt) do { __builtin_amdgcn_s_setprio(1); _Pragma("unroll") for (int m = 0; m < 4; ++m) _Pragma("unroll") for (int n = 0; n < 2; ++n) _Pragma("unroll") for (int k = 0; k < 2; ++k) \
        acc[ai][bj][m][n] = __builtin_amdgcn_mfma_f32_16x16x32_bf16(Bt[n][k], At[m][k], acc[ai][bj][m][n], 0, 0, 0); __builtin_amdgcn_s_setprio(0); } while (0)
#define PG8_WAIT_V(n) asm volatile("s_waitcnt vmcnt(" #n ")" ::: "memory")
#define PG8_WAIT_L(n) asm volatile("s_waitcnt lgkmcnt(" #n ")" ::: "memory")
#define PG8_BAR __builtin_amdgcn_s_barrier()
#define PG8_SCHED __builtin_amdgcn_sched_barrier(0)
    Unit cur, nxt; int ui = 0;
    if (!S.next(0, cur)) return;
    f32x4 acc[2][2][4][2];
#pragma unroll
    for (int a = 0; a < 2; ++a)
#pragma unroll
        for (int b = 0; b < 2; ++b)
#pragma unroll
            for (int m = 0; m < 4; ++m)
#pragma unroll
                for (int n = 0; n < 2; ++n) acc[a][b][m][n] = (f32x4){0.f, 0.f, 0.f, 0.f};
    bf16x8 At[4][2], B0[2][2], B1[2][2];
    const char* cA = (const char*)g.A + (size_t)cur.pm * tstep; const char* cB = (const char*)g.Bt + (size_t)cur.pn * tstep;
    S.a_ready(cur);
    if constexpr (SP2) {
        PG8_STAGE(PG8_SB(0, 0), cB, voffB); PG8_STAGE(PG8_SB(0, 1), cB + hstep, voffB); PG8_STAGE(PG8_SA(0, 0), cA, voffA); PG8_STAGE(PG8_SA(0, 1), cA + hstep, voffA);
        if (wr == 1) PG8_BAR;
        PG8_WAIT_V(2); PG8_BAR;
        PG8_STAGE(PG8_SB(1, 0), cB + kstep, voffB); PG8_STAGE(PG8_SA(1, 0), cA + kstep, voffA); PG8_STAGE(PG8_SB(1, 1), cB + hstep + kstep, voffB);
        PG8_WAIT_V(6); PG8_BAR;
    } else {
        PG8_STAGE(PG8_SB(0, 0), cB, voffB); PG8_STAGE(PG8_SA(0, 0), cA, voffA); PG8_STAGE(PG8_SB(0, 1), cB + hstep, voffB); PG8_STAGE(PG8_SA(0, 1), cA + hstep, voffA);
        if (wr == 1) PG8_BAR;
        PG8_WAIT_V(4); PG8_BAR;
        PG8_STAGE(PG8_SB(1, 0), cB + kstep, voffB); PG8_STAGE(PG8_SA(1, 0), cA + kstep, voffA); PG8_STAGE(PG8_SB(1, 1), cB + hstep + kstep, voffB);
        PG8_WAIT_V(6); PG8_BAR;
    }
    for (;;) {
        const bool has_next = S.next(ui + 1, nxt);
        const char* nA = has_next ? (const char*)g.A + (size_t)nxt.pm * tstep : cA; const char* nB = has_next ? (const char*)g.Bt + (size_t)nxt.pn * tstep : cB;
        for (int t = 0; t < nt; t += 2) {
            const bool last = (t == nt - 2);
            const char* a1 = cA + (size_t)(t + 1) * kstep;
            const char* a2 = last ? nA : cA + (size_t)(t + 2) * kstep; const char* b2 = last ? nB : cB + (size_t)(t + 2) * kstep;
            const char* a3 = a2 + kstep; const char* b3 = b2 + kstep;
            if (last && has_next) S.a_ready(nxt);
            if constexpr (SP2) {
            PG8_LDB(B0, 0, 0); PG8_LDB(B1, 0, 1); PG8_SCHED; PG8_LDA(At, 0, 0); PG8_STAGE(PG8_SA(1, 1), a1 + hstep, voffA);
            PG8_WAIT_V(8); PG8_WAIT_L(0); PG8_BAR; PG8_MMA(0, 0, At, B0); PG8_MMA(0, 1, At, B1); PG8_BAR; PG8_SCHED;
            PG8_LDA(At, 0, 1); PG8_STAGE(PG8_SB(0, 0), b2, voffB); PG8_STAGE(PG8_SB(0, 1), b2 + hstep, voffB); PG8_STAGE(PG8_SA(0, 0), a2, voffA);
            PG8_WAIT_V(8); PG8_WAIT_L(0); PG8_BAR; PG8_MMA(1, 0, At, B0); PG8_MMA(1, 1, At, B1); PG8_BAR; PG8_SCHED;
            PG8_LDB(B0, 1, 0); PG8_LDB(B1, 1, 1); PG8_SCHED; PG8_LDA(At, 1, 0); PG8_STAGE(PG8_SA(0, 1), a2 + hstep, voffA);
            PG8_WAIT_V(8); PG8_WAIT_L(0); PG8_BAR; PG8_MMA(0, 0, At, B0); PG8_MMA(0, 1, At, B1); PG8_BAR; PG8_SCHED;
            PG8_LDA(At, 1, 1); PG8_STAGE(PG8_SB(1, 0), b3, voffB); PG8_STAGE(PG8_SB(1, 1), b3 + hstep, voffB); PG8_STAGE(PG8_SA(1, 0), a3, voffA);
            PG8_WAIT_V(8); PG8_WAIT_L(0); PG8_BAR; PG8_MMA(1, 0, At, B0); PG8_MMA(1, 1, At, B1); PG8_BAR; PG8_SCHED;
            } else {
            PG8_LDB(B0, 0, 0); PG8_SCHED; PG8_LDA(At, 0, 0); PG8_STAGE(PG8_SA(1, 1), a1 + hstep, voffA);
            PG8_WAIT_L(8); PG8_BAR; PG8_WAIT_L(0); PG8_MMA(0, 0, At, B0); PG8_BAR; PG8_SCHED;
            PG8_LDB(B1, 0, 1); PG8_STAGE(PG8_SB(0, 0), b2, voffB);
            PG8_BAR; PG8_WAIT_L(0); PG8_MMA(0, 1, At, B1); PG8_BAR;
            PG8_LDA(At, 0, 1); PG8_STAGE(PG8_SA(0, 0), a2, voffA);
            PG8_BAR; PG8_WAIT_L(0); PG8_MMA(1, 0, At, B0); PG8_BAR; PG8_SCHED;
            PG8_STAGE(PG8_SB(0, 1), b2 + hstep, voffB);
            PG8_WAIT_V(6); PG8_BAR; PG8_MMA(1, 1, At, B1); PG8_BAR;
            PG8_LDB(B0, 1, 0); PG8_SCHED; PG8_LDA(At, 1, 0); PG8_STAGE(PG8_SA(0, 1), a2 + hstep, voffA);
            PG8_WAIT_L(8); PG8_BAR; PG8_WAIT_L(0); PG8_MMA(0, 0, At, B0); PG8_BAR; PG8_SCHED;
            PG8_LDB(B1, 1, 1); PG8_STAGE(PG8_SB(1, 0), b3, voffB);
            PG8_BAR; PG8_WAIT_L(0); PG8_MMA(0, 1, At, B1); PG8_BAR;
            PG8_LDA(At, 1, 1); PG8_STAGE(PG8_SA(1, 0), a3, voffA);
            PG8_BAR; PG8_WAIT_L(0); PG8_MMA(1, 0, At, B0); PG8_BAR; PG8_SCHED;
            PG8_STAGE(PG8_SB(1, 1), b3 + hstep, voffB);
            PG8_WAIT_V(6); PG8_BAR; PG8_MMA(1, 1, At, B1); PG8_BAR;
            }
        }
        if constexpr (ALIGN_EPI) { if (wr == 0) PG8_BAR; }
        if constexpr (!Epi::AFTER_DRAIN) { E(acc, cur, wr, wc, fr, fq); S.done(cur); }
        if (!has_next) break;
#pragma unroll
        for (int a = 0; a < 2; ++a)
#pragma unroll
            for (int b = 0; b < 2; ++b)
#pragma unroll
                for (int m = 0; m < 4; ++m)
#pragma unroll
                    for (int n = 0; n < 2; ++n) acc[a][b][m][n] = (f32x4){0.f, 0.f, 0.f, 0.f};
        cur = nxt; cA = nA; cB = nB; ++ui;
        if constexpr (ALIGN_EPI) { if (wr == 1) PG8_BAR; }
    }
    PG8_WAIT_V(0);
    if constexpr (!ALIGN_EPI) { if (wr == 0) PG8_BAR; }
    PG8_BAR;
    if constexpr (Epi::AFTER_DRAIN) { E.fused(acc, cur, wr, wc, fr, fq, lds, wid, lane); S.done(cur); }
#undef PG8_SA
#undef PG8_SB
#undef PG8_STAGE
#undef PG8_LDA
#undef PG8_LDB
#undef PG8_MMA
#undef PG8_WAIT_V
#undef PG8_WAIT_L
#undef PG8_BAR
#undef PG8_SCHED
}
}
#define GAS __attribute__((address_space(1)))
#define LAS __attribute__((address_space(3)))
typedef unsigned short bf16;
typedef unsigned v4u __attribute__((ext_vector_type(4)));
typedef float f32x4 __attribute__((ext_vector_type(4)));
typedef short bf16x8 __attribute__((ext_vector_type(8)));
typedef GAS unsigned gu32;
typedef GAS unsigned long long gu64;
#define RLX_AGENT __ATOMIC_RELAXED, __HIP_MEMORY_SCOPE_AGENT
#define LDS_WAIT() asm volatile("s_waitcnt lgkmcnt(0)" ::: "memory")
#define VM_WAIT() asm volatile("s_waitcnt vmcnt(0)" ::: "memory")
__device__ __forceinline__ unsigned long long rt() { return __builtin_amdgcn_s_memrealtime(); }
__device__ __forceinline__ unsigned f2bf(float f) { unsigned u = __builtin_bit_cast(unsigned, f); return (u + 0x7fffu + ((u >> 16) & 1u)) >> 16; }
__device__ __forceinline__ unsigned pk2(float lo, float hi) { return f2bf(lo) | (f2bf(hi) << 16); }

#define XB_TMO      128
#define XB_XCNT(j)  (256  + 64 * (j))
#define XB_XSUB(j)  (1280 + 64 * (j))
#define XB_XGEN(j)  (2304 + 64 * (j))
#define XB_TOP      3328
#define XB_TOPGEN   3392
#define XCD_BAR_WORDS 3456
#define XB_SPIN_CAP (1u << 18)

__device__ __forceinline__ unsigned xb_ld(unsigned* p)              { return __hip_atomic_load(p, __ATOMIC_RELAXED, __HIP_MEMORY_SCOPE_AGENT); }
__device__ __forceinline__ unsigned xb_add(unsigned* p, unsigned v) { return __hip_atomic_fetch_add(p, v, __ATOMIC_RELAXED, __HIP_MEMORY_SCOPE_AGENT); }
__device__ __forceinline__ unsigned xb_xcc_id() { return (unsigned)__builtin_amdgcn_s_getreg((3 << 11) | 20) & 0xFu; }
#define XB_SPIN(cond, bar) do { unsigned _sp = 0; while (cond) { __builtin_amdgcn_s_sleep(1); \
    if ((++_sp & 255u) == 0u) { if (xb_ld(&(bar)[XB_TMO])) break; if (_sp > XB_SPIN_CAP) { atomicAdd(&(bar)[XB_TMO], 1u); break; } } } } while (0)

struct XcdBarrier {
    unsigned* bar; unsigned x;
    volatile LAS unsigned* st;
};

__device__ __forceinline__ XcdBarrier xcd_barrier_post(unsigned* bar, volatile LAS unsigned* st) {
    XcdBarrier b; b.bar = bar; b.x = xb_xcc_id(); b.st = st;
    if (threadIdx.x == 0) (void)xb_add(&bar[XB_XCNT(b.x)], 1u);
    return b;
}
__device__ __forceinline__ void xcd_barrier_complete(unsigned* bar, unsigned x, unsigned& nloc, unsigned& nx) {
    const unsigned G = gridDim.x * gridDim.y * gridDim.z;
    unsigned sum, cnt, mine, sp = 0u;
    for (;;) {
        sum = 0u; cnt = 0u; mine = 0u;
#pragma unroll
        for (unsigned j = 0; j < 16; ++j) { const unsigned c = xb_ld(&bar[XB_XCNT(j)]); sum += c; cnt += (c > 0u) ? 1u : 0u; mine = (j == x) ? c : mine; }
        if (sum == G) break;
        __builtin_amdgcn_s_sleep(1);
        if ((++sp & 255u) == 0u) { if (xb_ld(&bar[XB_TMO])) break; if (sp > XB_SPIN_CAP) { atomicAdd(&bar[XB_TMO], 1u); break; } }
    }
    nloc = mine > 0u ? mine : 1u; nx = cnt > 0u ? cnt : 1u;
}

__device__ __forceinline__ void xcd_barrier(const XcdBarrier& b) {
    asm volatile("s_waitcnt vmcnt(0)" ::: "memory");
    __syncthreads();
    if (threadIdx.x == 0) {
        unsigned* bar = b.bar;
        __builtin_amdgcn_s_waitcnt(0);
        unsigned nloc = b.st[0], nx = b.st[1];
        if (nloc == 0u) { xcd_barrier_complete(bar, b.x, nloc, nx); b.st[0] = nloc; b.st[1] = nx; }
        const unsigned old = xb_add(&bar[XB_XSUB(b.x)], 1u);
        const unsigned gen = old / nloc;
        if (old + 1u == (gen + 1u) * nloc) {
            __builtin_amdgcn_fence(__ATOMIC_RELEASE, "agent");
            asm volatile("s_waitcnt vmcnt(0)" ::: "memory");
            const unsigned og = xb_add(&bar[XB_TOP], 1u);
            const unsigned tg = og / nx;
            if (og + 1u == (tg + 1u) * nx) xb_add(&bar[XB_TOPGEN], 1u);
            else XB_SPIN(xb_ld(&bar[XB_TOPGEN]) == tg, bar);
            __builtin_amdgcn_fence(__ATOMIC_ACQUIRE, "agent");
            xb_add(&bar[XB_XGEN(b.x)], 1u);
            asm volatile("s_waitcnt vmcnt(0)" ::: "memory");
        } else {
            XB_SPIN(xb_ld(&bar[XB_XGEN(b.x)]) == gen, bar);
            __builtin_amdgcn_fence(__ATOMIC_ACQUIRE, "agent");
            asm volatile("s_waitcnt vmcnt(0)" ::: "memory");
        }
    }
    __syncthreads();
}

constexpr int NWAVES = 8, NTHR = NWAVES * 64;
constexpr int BATCH = 8, SEQ = 2048, D = 1024, M = BATCH * SEQ, FF = 2816, NIN = 10272;
constexpr int SSD_INNER = 2048, SSD_H = 32, SSD_P = 64, SSD_N = 128, CONV_CH = 3072;
constexpr int DA_H = 8;
constexpr float EPS = 1e-6f, LOG2E = 1.4426950408889634f;
constexpr float QSCALE = 0.125f * LOG2E;
constexpr float LAM_INIT = 0.2f;
constexpr int NPH = 18;
enum { I_X = 0, I_F1_PRE, I_F1_WG, I_F1_WU, I_F1_WD, I_F1_POST, I_MIX_PRE, I_WIN, I_GATE_B, I_CONV_W, I_CONV_B, I_DT_BIAS, I_A_LOG, I_SSD_D, I_SSD_NORM, I_SSD_W,
       I_LQ1, I_LK1, I_LQ2, I_LK2, I_SUBLN, I_DA_W, I_WOUT, I_MIX_POST, I_F2_PRE, I_F2_WG, I_F2_WU, I_F2_WD, I_F2_POST, N_INPUTS };

constexpr size_t MiB = 1u << 20;
constexpr size_t WS_CTL = 0, CTL_ZERO_BYTES = 1 * MiB;
constexpr size_t WS_WGU = 1 * MiB, WS_WD = 12 * MiB, WS_WQKV = 18 * MiB, WS_WZX = 24 * MiB, WS_WGATE = 34 * MiB, WS_WSSD = 38 * MiB, WS_WDA = 42 * MiB, WS_WOUT = 44 * MiB, WS_WDT = 46 * MiB;
constexpr size_t WS_F1N = 48 * MiB, WS_XN = 80 * MiB;
constexpr size_t WS_H = 112 * MiB;
constexpr size_t WS_Q = 112 * MiB, WS_K = 144 * MiB, WS_V = 176 * MiB;
constexpr size_t WS_AN = 112 * MiB;
constexpr size_t WS_XBC = 144 * MiB;
constexpr size_t WS_DT = 240 * MiB, WS_SSQP = 242 * MiB;
constexpr size_t WS_GATES = 144 * MiB, WS_MERGED = 208 * MiB;
constexpr size_t WS_TMP = 48 * MiB;
constexpr size_t WS_END = 256 * MiB;
constexpr int CW_TMO = 0, CW_CODE = 1, CW_BAR = 4096;

constexpr int RING_OFF = 0, RING_BYTES = 131072;
constexpr int LDSCTL_OFF = RING_BYTES, MISC_OFF = LDSCTL_OFF + 320;
constexpr int LDS_BYTES = 147456;

struct Args { const float* in[N_INPUTS]; float* out; unsigned char* ws; int ph_lo, ph_hi; int pad0, pad1; };
static_assert(sizeof(Args) == N_INPUTS * 8 + 8 + 8 + 16, "Args has no padding holes");

struct Ctx { LAS unsigned char* lds; int tid, lane, wave, vcu, G; };

__device__ __forceinline__ float wave_sum(float v) {
#pragma unroll
    for (int o = 1; o < 64; o <<= 1) v += __shfl_xor(v, o);
    return v;
}
__device__ __forceinline__ float bflo(unsigned w) { return __uint_as_float(w << 16); }
__device__ __forceinline__ float bfhi(unsigned w) { return __uint_as_float(w & 0xffff0000u); }
__device__ __forceinline__ float bf1(bf16 h) { return __uint_as_float((unsigned)h << 16); }
__device__ __forceinline__ float sigm(float x) { return 1.0f / (1.0f + __expf(-x)); }

__device__ __forceinline__ void transpose_item(const float* W, int ldw, int K, bf16* WT, int dst_row0, int k0, int n0, LAS float* scr, int lane) {
#pragma unroll 8
    for (int i = 0; i < 32; ++i) { const int kk = 2 * i + (lane >> 5); scr[kk * 33 + (lane & 31)] = W[(size_t)(k0 + kk) * ldw + n0 + (lane & 31)]; }
    LDS_WAIT(); asm volatile("" ::: "memory");
    const int c = lane & 7;
#pragma unroll
    for (int j = 0; j < 4; ++j) { const int n = (lane >> 3) + 8 * j; const LAS float* s = scr + (8 * c) * 33 + n;
        v4u o; o.x = pk2(s[0 * 33], s[1 * 33]); o.y = pk2(s[2 * 33], s[3 * 33]); o.z = pk2(s[4 * 33], s[5 * 33]); o.w = pk2(s[6 * 33], s[7 * 33]);
        *(GAS v4u*)(WT + (size_t)(dst_row0 + n) * K + k0 + 8 * c) = o; }
    LDS_WAIT(); asm volatile("" ::: "memory");
}
constexpr int FFN_ITEMS = 3 * 16 * 88;
__device__ __forceinline__ void ffn_weight_item(const float* wg, const float* wu, const float* wd, unsigned char* ws, int it, LAS float* scr, int lane) {
    bf16* WGU = (bf16*)(ws + WS_WGU); bf16* WD = (bf16*)(ws + WS_WD);
    if (it < 2 * 1408) { const bool up = it >= 1408; const int r = up ? it - 1408 : it; const int kb = r / 88, nb = r % 88, n0 = nb * 32;
        transpose_item(up ? wu : wg, FF, D, WGU, 256 * (n0 >> 7) + (up ? 128 : 0) + (n0 & 127), kb * 64, n0, scr, lane); }
    else { const int r = it - 2 * 1408; const int kb = r / 32, nb = r % 32;
        transpose_item(wd, D, FF, WD, nb * 32, kb * 64, nb * 32, scr, lane); }
}
constexpr int WIN_ITEMS = 16 * 321, WSSD_ITEMS = 32 * 32, WSQ_ITEMS = 16 * 32;
__device__ __forceinline__ void mixer_weight_item(const Args& a, int it, LAS float* scr, int lane) {
    unsigned char* ws = a.ws;
    if (it < WIN_ITEMS) { const int kb = it / 321, nb = it % 321, n0 = nb * 32; bf16* dst; int row;
        if (n0 < 5120) { dst = (bf16*)(ws + WS_WZX); row = n0; }
        else if (n0 < 5152) { dst = (bf16*)(ws + WS_WDT); row = n0 - 5120; }
        else if (n0 < 8224) { dst = (bf16*)(ws + WS_WQKV); row = n0 - 5152; }
        else { dst = (bf16*)(ws + WS_WGATE); row = n0 - 8224; }
        transpose_item(a.in[I_WIN], NIN, D, dst, row, kb * 64, n0, scr, lane); return; }
    it -= WIN_ITEMS;
    if (it < WSSD_ITEMS) { const int kb = it / 32, nb = it % 32; transpose_item(a.in[I_SSD_W], D, SSD_INNER, (bf16*)(ws + WS_WSSD), nb * 32, kb * 64, nb * 32, scr, lane); return; }
    it -= WSSD_ITEMS;
    if (it < WSQ_ITEMS) { const int kb = it / 32, nb = it % 32; transpose_item(a.in[I_DA_W], D, D, (bf16*)(ws + WS_WDA), nb * 32, kb * 64, nb * 32, scr, lane); return; }
    it -= WSQ_ITEMS;
    { const int kb = it / 32, nb = it % 32; transpose_item(a.in[I_WOUT], D, D, (bf16*)(ws + WS_WOUT), nb * 32, kb * 64, nb * 32, scr, lane); }
}
constexpr int MIXER_ITEMS = WIN_ITEMS + WSSD_ITEMS + 2 * WSQ_ITEMS;

__device__ __forceinline__ void row_load(const float* row, int lane, f32x4 (&v)[4]) {
    const GAS f32x4* p = (const GAS f32x4*)row + lane;
#pragma unroll
    for (int j = 0; j < 4; ++j) v[j] = p[64 * j];
}
__device__ __forceinline__ void row_store(float* row, int lane, const f32x4 (&v)[4]) {
    GAS f32x4* p = (GAS f32x4*)row + lane;
#pragma unroll
    for (int j = 0; j < 4; ++j) p[64 * j] = v[j];
}
__device__ __forceinline__ void row_load_bf(const bf16* row, int lane, f32x4 (&v)[4]) {
    const GAS unsigned long long* p = (const GAS unsigned long long*)row + lane;
#pragma unroll
    for (int j = 0; j < 4; ++j) { const unsigned long long w = p[64 * j]; const unsigned lo = (unsigned)w, hi = (unsigned)(w >> 32); v[j] = (f32x4){bflo(lo), bfhi(lo), bflo(hi), bfhi(hi)}; }
}
__device__ __forceinline__ void row_store_bf_round(bf16* row, int lane, f32x4 (&v)[4]) {
    GAS unsigned long long* p = (GAS unsigned long long*)row + lane;
#pragma unroll
    for (int j = 0; j < 4; ++j) { const unsigned lo = pk2(v[j].x, v[j].y), hi = pk2(v[j].z, v[j].w); p[64 * j] = (unsigned long long)lo | ((unsigned long long)hi << 32);
        v[j] = (f32x4){bflo(lo), bfhi(lo), bflo(hi), bfhi(hi)}; }
}
__device__ __forceinline__ float row_rstd(const f32x4 (&v)[4]) {
    float s = 0.f;
#pragma unroll
    for (int j = 0; j < 4; ++j) s += (v[j].x * v[j].x + v[j].y * v[j].y) + (v[j].z * v[j].z + v[j].w * v[j].w);
    return 1.0f / sqrtf(wave_sum(s) * (1.0f / D) + EPS);
}
__device__ __forceinline__ void row_scale_gain(f32x4 (&v)[4], float s, const float* g, int lane) {
    const GAS f32x4* p = (const GAS f32x4*)g + lane;
#pragma unroll
    for (int j = 0; j < 4; ++j) v[j] = v[j] * s * p[64 * j];
}

__device__ __forceinline__ void ph_prologue(const Args& a, const Ctx& c) {
    LAS float* scr = (LAS float*)(c.lds + RING_OFF + c.wave * 16384);
    const int gw = c.vcu * NWAVES + c.wave, NGW = c.G * NWAVES;
    for (int it = gw; it < FFN_ITEMS + MIXER_ITEMS; it += NGW) {
        if (it < FFN_ITEMS) ffn_weight_item(a.in[I_F1_WG], a.in[I_F1_WU], a.in[I_F1_WD], a.ws, it, scr, c.lane);
        else mixer_weight_item(a, it - FFN_ITEMS, scr, c.lane);
    }
    bf16* XN = (bf16*)(a.ws + WS_XN);
    for (int m = gw; m < M; m += NGW) { f32x4 v[4]; row_load(a.in[I_X] + (size_t)m * D, c.lane, v); const float r = row_rstd(v); row_scale_gain(v, r, a.in[I_F1_PRE], c.lane); row_store_bf_round(XN + (size_t)m * D, c.lane, v); }
}
__device__ __forceinline__ void ph_e2(const Args& a, const Ctx& c) {
    const int gw = c.vcu * NWAVES + c.wave, NGW = c.G * NWAVES; bf16* XN = (bf16*)(a.ws + WS_XN); bf16* F1N = (bf16*)(a.ws + WS_F1N);
    for (int m = gw; m < M; m += NGW) { f32x4 v[4], x[4]; row_load(a.out + (size_t)m * D, c.lane, v); row_load(a.in[I_X] + (size_t)m * D, c.lane, x);
        const float r = row_rstd(v); row_scale_gain(v, 0.5f * r, a.in[I_F1_POST], c.lane); row_store_bf_round(F1N + (size_t)m * D, c.lane, v);
#pragma unroll
        for (int j = 0; j < 4; ++j) v[j] = v[j] + x[j];
        const float r2 = row_rstd(v); row_scale_gain(v, r2, a.in[I_MIX_PRE], c.lane); row_store_bf_round(XN + (size_t)m * D, c.lane, v); }
}
__device__ __forceinline__ void ph_e8(const Args& a, const Ctx& c) {
    const int gw = c.vcu * NWAVES + c.wave, NGW = c.G * NWAVES; bf16* XN = (bf16*)(a.ws + WS_XN); const bf16* F1N = (const bf16*)(a.ws + WS_F1N);
    for (int m = gw; m < M; m += NGW) { f32x4 v[4], x[4], f[4]; row_load(a.out + (size_t)m * D, c.lane, v); row_load(a.in[I_X] + (size_t)m * D, c.lane, x); row_load_bf(F1N + (size_t)m * D, c.lane, f);
        const float r = row_rstd(v); row_scale_gain(v, r, a.in[I_MIX_POST], c.lane);
#pragma unroll
        for (int j = 0; j < 4; ++j) v[j] = v[j] + x[j] + f[j];
        row_store(a.out + (size_t)m * D, c.lane, v);
        const float r2 = row_rstd(v); row_scale_gain(v, r2, a.in[I_F2_PRE], c.lane); row_store_bf_round(XN + (size_t)m * D, c.lane, v); }
}
__device__ __forceinline__ void ph_e10(const Args& a, const Ctx& c) {
    const int gw = c.vcu * NWAVES + c.wave, NGW = c.G * NWAVES; const float* TMP = (const float*)(a.ws + WS_TMP);
    for (int m = gw; m < M; m += NGW) { f32x4 v[4], h[4]; row_load(TMP + (size_t)m * D, c.lane, v); row_load(a.out + (size_t)m * D, c.lane, h);
        const float r = row_rstd(v); row_scale_gain(v, 0.5f * r, a.in[I_F2_POST], c.lane);
#pragma unroll
        for (int j = 0; j < 4; ++j) v[j] = v[j] + h[j];
        row_store(a.out + (size_t)m * D, c.lane, v); }
}
__device__ __forceinline__ void ph_attn_simple(const Args& a, const Ctx& c) {
    const bf16* Q = (const bf16*)(a.ws + WS_Q); const bf16* K = (const bf16*)(a.ws + WS_K); const bf16* V = (const bf16*)(a.ws + WS_V); bf16* O = (bf16*)a.out;
    for (int item = c.vcu; item < BATCH * 32; item += c.G) {
        const int b = item >> 5, hm = (item >> 1) & 15, vh = item & 1, h = hm >> 1;
        const float sl2 = exp2f(-(float)(h + 1)) * LOG2E;
        for (int r = 0; r < 4; ++r) {
            const int qpos = c.tid + NTHR * r; const size_t qrow = (size_t)(b * SEQ + qpos);
            float q[64], o[64];
            { const GAS v4u* qp = (const GAS v4u*)(Q + qrow * 1024 + hm * 64);
#pragma unroll
              for (int i = 0; i < 8; ++i) { const v4u w = qp[i]; q[8 * i] = bflo(w.x); q[8 * i + 1] = bfhi(w.x); q[8 * i + 2] = bflo(w.y); q[8 * i + 3] = bfhi(w.y); q[8 * i + 4] = bflo(w.z); q[8 * i + 5] = bfhi(w.z); q[8 * i + 6] = bflo(w.w); q[8 * i + 7] = bfhi(w.w); } }
#pragma unroll
            for (int d = 0; d < 64; ++d) o[d] = 0.f;
            float mrun = -1e30f, l = 0.f;
            const int jmax = qpos | 63;
            for (int j = 0; j <= jmax; ++j) {
                const GAS v4u* kp = (const GAS v4u*)(K + (size_t)(b * SEQ + j) * 1024 + hm * 64);
                const GAS v4u* vp = (const GAS v4u*)(V + (size_t)(b * SEQ + j) * 1024 + h * 128 + vh * 64);
                float s = 0.f;
#pragma unroll
                for (int i = 0; i < 8; ++i) { const v4u w = kp[i]; s += q[8 * i] * bflo(w.x) + q[8 * i + 1] * bfhi(w.x) + q[8 * i + 2] * bflo(w.y) + q[8 * i + 3] * bfhi(w.y) + q[8 * i + 4] * bflo(w.z) + q[8 * i + 5] * bfhi(w.z) + q[8 * i + 6] * bflo(w.w) + q[8 * i + 7] * bfhi(w.w); }
                s += sl2 * (float)(j - qpos);
                if (j <= qpos) {
                    const float mn = fmaxf(mrun, s), al = exp2f(mrun - mn), p = exp2f(s - mn); l = l * al + p; mrun = mn;
#pragma unroll
                    for (int i = 0; i < 8; ++i) { const v4u w = vp[i];
                        o[8 * i] = o[8 * i] * al + p * bflo(w.x); o[8 * i + 1] = o[8 * i + 1] * al + p * bfhi(w.x); o[8 * i + 2] = o[8 * i + 2] * al + p * bflo(w.y); o[8 * i + 3] = o[8 * i + 3] * al + p * bfhi(w.y);
                        o[8 * i + 4] = o[8 * i + 4] * al + p * bflo(w.z); o[8 * i + 5] = o[8 * i + 5] * al + p * bfhi(w.z); o[8 * i + 6] = o[8 * i + 6] * al + p * bflo(w.w); o[8 * i + 7] = o[8 * i + 7] * al + p * bfhi(w.w); }
                }
            }
            const float rl = 1.0f / l; GAS v4u* op = (GAS v4u*)(O + qrow * 2048 + hm * 128 + vh * 64);
#pragma unroll
            for (int i = 0; i < 8; ++i) { v4u w; w.x = pk2(o[8 * i] * rl, o[8 * i + 1] * rl); w.y = pk2(o[8 * i + 2] * rl, o[8 * i + 3] * rl); w.z = pk2(o[8 * i + 4] * rl, o[8 * i + 5] * rl); w.w = pk2(o[8 * i + 6] * rl, o[8 * i + 7] * rl); op[i] = w; }
        }
    }
}
__device__ __forceinline__ void ph_attn_final(const Args& a, const Ctx& c) {
    const int gw = c.vcu * NWAVES + c.wave, NGW = c.G * NWAVES;
    { LAS float* scr = (LAS float*)(c.lds + RING_OFF + c.wave * 16384);
      for (int it = gw; it < FFN_ITEMS; it += NGW) ffn_weight_item(a.in[I_F2_WG], a.in[I_F2_WU], a.in[I_F2_WD], a.ws, it, scr, c.lane); }
    const float s1 = wave_sum(a.in[I_LQ1][c.lane] * a.in[I_LK1][c.lane]), s2 = wave_sum(a.in[I_LQ2][c.lane] * a.in[I_LK2][c.lane]);
    const float lam = __expf(s1) - __expf(s2) + LAM_INIT;
    const float g0 = a.in[I_SUBLN][2 * c.lane] * (1.0f - LAM_INIT), g1 = a.in[I_SUBLN][2 * c.lane + 1] * (1.0f - LAM_INIT);
    const bf16* O = (const bf16*)a.out; bf16* AN = (bf16*)(a.ws + WS_AN);
    for (int m = gw; m < M; m += NGW) {
        const GAS unsigned* op = (const GAS unsigned*)(O + (size_t)m * 2048) + c.lane; GAS unsigned* ap = (GAS unsigned*)(AN + (size_t)m * 1024) + c.lane;
#pragma unroll
        for (int h = 0; h < DA_H; ++h) { const unsigned w0 = op[h * 128], w1 = op[h * 128 + 64];
            const float x0 = bflo(w0) - lam * bflo(w1), x1 = bfhi(w0) - lam * bfhi(w1);
            const float r = 1.0f / sqrtf(wave_sum(x0 * x0 + x1 * x1) * (1.0f / 128.0f) + EPS);
            ap[h * 64] = pk2(x0 * r * g0, x1 * r * g1); }
    }
}
__device__ __forceinline__ void ph_dt(const Args& a, const Ctx& c) {
    const bf16* XN = (const bf16*)(a.ws + WS_XN); const bf16* WDT = (const bf16*)(a.ws + WS_WDT); float* DT = (float*)(a.ws + WS_DT);
    for (int idx = c.vcu * NTHR + c.tid; idx < M * SSD_H; idx += c.G * NTHR) {
        const int t = idx >> 5, h = idx & 31; const GAS v4u* xp = (const GAS v4u*)(XN + (size_t)t * D); const GAS v4u* wp = (const GAS v4u*)(WDT + (size_t)h * D);
        float s = 0.f;
        for (int i = 0; i < D / 8; ++i) { const v4u x = xp[i], w = wp[i];
            s += bflo(x.x) * bflo(w.x) + bfhi(x.x) * bfhi(w.x) + bflo(x.y) * bflo(w.y) + bfhi(x.y) * bfhi(w.y) + bflo(x.z) * bflo(w.z) + bfhi(x.z) * bfhi(w.z) + bflo(x.w) * bflo(w.w) + bfhi(x.w) * bfhi(w.w); }
        s += a.in[I_DT_BIAS][h];
        DT[idx] = s > 20.f ? s : log1pf(__expf(s));
    }
}
__device__ __forceinline__ void ph_ssd_simple(const Args& a, const Ctx& c) {
    bf16* Z = (bf16*)a.out; const bf16* XBC = (const bf16*)(a.ws + WS_XBC); const float* DT = (const float*)(a.ws + WS_DT); float* SSQP = (float*)(a.ws + WS_SSQP);
    LAS float* xL = (LAS float*)(c.lds); LAS float* BL = xL + 64 * 64; LAS float* CL = BL + 64 * 128; LAS float* yL = CL + 64 * 128; LAS float* dtL = yL + 64 * 64;
    const float* cw = a.in[I_CONV_W]; const float* cb = a.in[I_CONV_B];
    for (int item = c.vcu; item < BATCH * SSD_H; item += c.G) {
        const int b = item >> 5, h = item & 31, g = h >> 3;
        const float Ah = -__expf(a.in[I_A_LOG][h]), Dh = a.in[I_SSD_D][h];
        const int p = c.tid >> 3, nq = c.tid & 7;
        float st[16];
#pragma unroll
        for (int i = 0; i < 16; ++i) st[i] = 0.f;
        for (int sub = 0; sub < SEQ / 64; ++sub) {
            const int t0 = sub * 64;
            for (int idx = c.tid; idx < 64 * 320; idx += NTHR) {
                const int tl = idx / 320, ch = idx % 320;
                const int gc = ch < 64 ? h * 64 + ch : (ch < 192 ? 2048 + g * 128 + (ch - 64) : 2560 + g * 128 + (ch - 192));
                float acc = cb[gc];
#pragma unroll
                for (int j = 0; j < 4; ++j) { const int tt = t0 + tl - 3 + j; if (tt >= 0) acc += cw[j * CONV_CH + gc] * bf1(XBC[(size_t)(b * SEQ + tt) * CONV_CH + gc]); }
                const float v = acc * sigm(acc);
                if (ch < 64) xL[tl * 64 + ch] = v; else if (ch < 192) BL[tl * 128 + ch - 64] = v; else CL[tl * 128 + ch - 192] = v;
            }
            if (c.tid < 64) dtL[c.tid] = DT[(size_t)(b * SEQ + t0 + c.tid) * SSD_H + h];
            __syncthreads();
            for (int tl = 0; tl < 64; ++tl) {
                const float dtv = dtL[tl], dA = __expf(dtv * Ah), xv = xL[tl * 64 + p], coef = dtv * xv;
                const LAS f32x4* bp = (const LAS f32x4*)(BL + tl * 128 + nq * 16); const LAS f32x4* cp = (const LAS f32x4*)(CL + tl * 128 + nq * 16);
                float ys = 0.f;
#pragma unroll
                for (int i = 0; i < 4; ++i) { const f32x4 bv = bp[i], cv = cp[i];
#pragma unroll
                    for (int k = 0; k < 4; ++k) { st[4 * i + k] = st[4 * i + k] * dA + coef * bv[k]; ys += cv[k] * st[4 * i + k]; } }
                ys += __shfl_xor(ys, 1); ys += __shfl_xor(ys, 2); ys += __shfl_xor(ys, 4);
                if (nq == 0) yL[tl * 64 + p] = ys + Dh * xv;
            }
            __syncthreads();
#pragma unroll
            for (int i = 0; i < 8; ++i) { const int idx = c.tid + NTHR * i, tl = idx >> 6, pp = idx & 63; const size_t t = (size_t)(b * SEQ + t0 + tl);
                bf16* zp = Z + t * SSD_INNER + h * 64 + pp; const float yp = yL[tl * 64 + pp] * bf1(*zp); const bf16 yb = (bf16)f2bf(yp); *zp = yb;
                const float yr = bf1(yb); const float sq = wave_sum(yr * yr); if (c.lane == 0) SSQP[t * SSD_H + h] = sq; }
            __syncthreads();
        }
    }
}
__device__ __forceinline__ void ph_ssd_final(const Args& a, const Ctx& c) {
    const int gw = c.vcu * NWAVES + c.wave, NGW = c.G * NWAVES; bf16* Y = (bf16*)a.out; const float* SSQP = (const float*)(a.ws + WS_SSQP); const float* ng = a.in[I_SSD_NORM];
    for (int m = gw; m < M; m += NGW) {
#pragma unroll
        for (int g = 0; g < 4; ++g) { float ss = 0.f;
#pragma unroll
            for (int i = 0; i < 8; ++i) ss += SSQP[(size_t)m * SSD_H + g * 8 + i];
            const float r = 1.0f / sqrtf(ss * (1.0f / 512.0f) + EPS);
            GAS v4u* yp = (GAS v4u*)(Y + (size_t)m * SSD_INNER + g * 512) + c.lane; const v4u w = *yp; const GAS f32x4* gp = (const GAS f32x4*)(ng + g * 512 + 8 * c.lane); const f32x4 g0 = gp[0], g1 = gp[1];
            v4u o; o.x = pk2(bflo(w.x) * r * g0.x, bfhi(w.x) * r * g0.y); o.y = pk2(bflo(w.y) * r * g0.z, bfhi(w.y) * r * g0.w); o.z = pk2(bflo(w.z) * r * g1.x, bfhi(w.z) * r * g1.y); o.w = pk2(bflo(w.w) * r * g1.z, bfhi(w.w) * r * g1.w);
            *yp = o; }
    }
}

__global__ void __launch_bounds__(NTHR, 2) skel_fwd(Args args) {
    extern __shared__ __attribute__((aligned(16))) unsigned char lds[];
    Ctx c;
    c.lds = (LAS unsigned char*)lds;
    volatile LAS unsigned* MISC = (volatile LAS unsigned*)(c.lds + MISC_OFF);
    c.tid = threadIdx.x; c.lane = c.tid & 63; c.wave = __builtin_amdgcn_readfirstlane(c.tid >> 6);
    c.G = gridDim.x; { const int bx = blockIdx.x; c.vcu = (c.G % 8 == 0) ? (bx % 8) * (c.G / 8) + bx / 8 : bx; }
    unsigned char* ws = args.ws;
    gu32* ctl = (gu32*)(ws + WS_CTL);
    for (int u = c.tid; u < (LDS_BYTES - LDSCTL_OFF) / 4; u += NTHR) ((LAS unsigned*)(c.lds + LDSCTL_OFF))[u] = 0u;
    __syncthreads();
    const int lo = args.ph_lo, hi = args.ph_hi;
    XcdBarrier bar; bar.bar = (unsigned*)(ctl + CW_BAR); bar.x = 0; bar.st = nullptr;
    if (hi - lo > 1) bar = xcd_barrier_post((unsigned*)(ctl + CW_BAR), MISC + 8);
#define IN(k) (lo <= (k) && (k) < hi)
#define SEAM(k) do { if (IN(k) && IN((k) + 1)) xcd_barrier(bar); } while (0)
    using namespace pg8;
    LAS unsigned char* ring = c.lds + RING_OFF;
    const bf16_t* XN = (const bf16_t*)(ws + WS_XN);

    if (IN(0)) { ph_prologue(args, c); } SEAM(0);
    if (IN(1)) { Gemm g{XN, (const bf16_t*)(ws + WS_WGU), M, 2 * FF, D}; StaticOrder S; S.init(M, 2 * FF, c.G, (int)blockIdx.x); EpiSwiGLU E{(bf16_t*)(ws + WS_H), FF};
        gemm_phase<EpiSwiGLU, StaticOrder, true, true>(ring, g, S, E); } SEAM(1);
    if (IN(2)) { Gemm g{(const bf16_t*)(ws + WS_H), (const bf16_t*)(ws + WS_WD), M, D, FF}; StaticOrder S; S.init(M, D, c.G, (int)blockIdx.x); EpiF32 E{args.out, D};
        gemm_phase<EpiF32, StaticOrder, true, true>(ring, g, S, E); } SEAM(2);
    if (IN(3)) { ph_e2(args, c); } SEAM(3);
    if (IN(4)) { Gemm g{XN, (const bf16_t*)(ws + WS_WQKV), M, 3 * D, D}; StaticOrder S; S.init(M, 3 * D, c.G, (int)blockIdx.x);
        EpiRow8<OpQKV> E{{(bf16_t*)(ws + WS_Q), (WS_K - WS_Q) / 2, QSCALE}};
        gemm_phase<EpiRow8<OpQKV>, StaticOrder, true, true>(ring, g, S, E); } SEAM(4);
    if (IN(5)) { ph_attn_simple(args, c); } SEAM(5);
    if (IN(6)) { ph_attn_final(args, c); } SEAM(6);
    if (IN(7)) { Gemm g{XN, (const bf16_t*)(ws + WS_WZX), M, 5120, D}; StaticOrder S; S.init(M, 5120, c.G, (int)blockIdx.x);
        EpiRow8<OpZX> E{{(bf16_t*)args.out, (bf16_t*)(ws + WS_XBC)}};
        gemm_phase<EpiRow8<OpZX>, StaticOrder, true, true>(ring, g, S, E);
        ph_dt(args, c); } SEAM(7);
    if (IN(8)) { ph_ssd_simple(args, c); } SEAM(8);
    if (IN(9)) { ph_ssd_final(args, c); } SEAM(9);
    if (IN(10)) { Gemm g{XN, (const bf16_t*)(ws + WS_WGATE), M, 2 * D, D}; StaticOrder S; S.init(M, 2 * D, c.G, (int)blockIdx.x);
        EpiRow8<OpGate> E{{(bf16_t*)(ws + WS_GATES), args.in[I_GATE_B]}};
        gemm_phase<EpiRow8<OpGate>, StaticOrder, true, true>(ring, g, S, E); } SEAM(10);
    if (IN(11)) { Gemm g{(const bf16_t*)args.out, (const bf16_t*)(ws + WS_WSSD), M, D, SSD_INNER}; StaticOrder S; S.init(M, D, c.G, (int)blockIdx.x);
        EpiRow8<OpMerge<true>> E{{(bf16_t*)(ws + WS_MERGED), (const bf16_t*)(ws + WS_GATES)}};
        gemm_phase<EpiRow8<OpMerge<true>>, StaticOrder, true, true>(ring, g, S, E); } SEAM(11);
    if (IN(12)) { Gemm g{(const bf16_t*)(ws + WS_AN), (const bf16_t*)(ws + WS_WDA), M, D, D}; StaticOrder S; S.init(M, D, c.G, (int)blockIdx.x);
        EpiRow8<OpMerge<false>> E{{(bf16_t*)(ws + WS_MERGED), (const bf16_t*)(ws + WS_GATES)}};
        gemm_phase<EpiRow8<OpMerge<false>>, StaticOrder, true, true>(ring, g, S, E); } SEAM(12);
    if (IN(13)) { Gemm g{(const bf16_t*)(ws + WS_MERGED), (const bf16_t*)(ws + WS_WOUT), M, D, D}; StaticOrder S; S.init(M, D, c.G, (int)blockIdx.x); EpiF32 E{args.out, D};
        gemm_phase<EpiF32, StaticOrder, true, true>(ring, g, S, E); } SEAM(13);
    if (IN(14)) { ph_e8(args, c); } SEAM(14);
    if (IN(15)) { Gemm g{XN, (const bf16_t*)(ws + WS_WGU), M, 2 * FF, D}; StaticOrder S; S.init(M, 2 * FF, c.G, (int)blockIdx.x); EpiSwiGLU E{(bf16_t*)(ws + WS_H), FF};
        gemm_phase<EpiSwiGLU, StaticOrder, true, true>(ring, g, S, E); } SEAM(15);
    if (IN(16)) { Gemm g{(const bf16_t*)(ws + WS_H), (const bf16_t*)(ws + WS_WD), M, D, FF}; StaticOrder S; S.init(M, D, c.G, (int)blockIdx.x); EpiF32 E{(float*)(ws + WS_TMP), D};
        gemm_phase<EpiF32, StaticOrder, true, true>(ring, g, S, E); } SEAM(16);
    if (IN(17)) { ph_e10(args, c); }
#undef IN
#undef SEAM
}

#ifndef MK_ONE_LAUNCH
#define MK_ONE_LAUNCH 0
#endif
extern "C" void kernel_launch(void* const* d_in, const int* in_sizes, int n_in, void* d_out, int out_size, void* d_ws, size_t ws_size, hipStream_t stream) {
    static int grid = 0;
    if (grid == 0) {
        if (n_in != N_INPUTS || in_sizes[0] != M * D || out_size != M * D || ws_size < WS_END) { fprintf(stderr, "kernel_launch: unexpected shapes (n_in %d, in0 %d, out %d, ws %zu); nothing launched\n", n_in, n_in > 0 ? in_sizes[0] : -1, out_size, ws_size); grid = -1; return; }
        int dev = 0, cus = 0, per_cu = 0;
        if (hipGetDevice(&dev) != hipSuccess || hipDeviceGetAttribute(&cus, hipDeviceAttributeMultiprocessorCount, dev) != hipSuccess) { grid = -1; return; }
        if (hipFuncSetAttribute((const void*)skel_fwd, hipFuncAttributeMaxDynamicSharedMemorySize, LDS_BYTES) != hipSuccess) { fprintf(stderr, "kernel_launch: hipFuncSetAttribute failed\n"); grid = -1; return; }
        if (hipOccupancyMaxActiveBlocksPerMultiprocessor(&per_cu, (const void*)skel_fwd, NTHR, LDS_BYTES) != hipSuccess || per_cu < 1) fprintf(stderr, "kernel_launch: occupancy query reports %d\n", per_cu);
        (void)hipGetLastError();
        grid = cus;
    }
    if (grid < 0) return;
    (void)hipMemsetAsync((char*)d_ws + WS_CTL, 0, CTL_ZERO_BYTES, stream);
    Args a{};
    for (int i = 0; i < N_INPUTS; ++i) a.in[i] = (const float*)d_in[i];
    a.out = (float*)d_out; a.ws = (unsigned char*)d_ws;
#if MK_ONE_LAUNCH
    a.ph_lo = 0; a.ph_hi = NPH;
    hipLaunchKernelGGL(skel_fwd, dim3(grid), dim3(NTHR), LDS_BYTES, stream, a);
#else
    for (int p = 0; p < NPH; ++p) { a.ph_lo = p; a.ph_hi = p + 1; hipLaunchKernelGGL(skel_fwd, dim3(grid), dim3(NTHR), LDS_BYTES, stream, a); }
#endif
}
```

```cpp
#include <hip/hip_runtime.h>
#include <cstdio>
#include <cstdint>
namespace pg8 {
#define PG8_LAS __attribute__((address_space(3)))
typedef unsigned short bf16_t;
typedef short bf16x8 __attribute__((ext_vector_type(8)));
typedef float f32x4 __attribute__((ext_vector_type(4)));
typedef unsigned u32x4 __attribute__((ext_vector_type(4)));
constexpr int BM = 256, BK = 64, HALF = 128, HTB = HALF * BK * 2  , STAGE_BYTES = 8 * HTB, NXCD = 8, WGM = 8;

__host__ __device__ __forceinline__ int lds_byte(int r, int c) { const int st = (r >> 4) * 2 + (c >> 5), rr = r & 15, cc = c & 31, ob = rr * 64 + cc * 2; return st * 1024 + (ob ^ (((ob >> 9) & 1) << 5)); }
__host__ __device__ __forceinline__ void stage_rc(int b, int& R, int& C) { const int st = b / 1024, sb = b % 1024, swz = sb ^ (((sb >> 9) & 1) << 5); R = (st >> 1) * 16 + swz / 64; C = (st & 1) * 32 + (swz % 64) / 2; }
__host__ __device__ __forceinline__ int perm32(int rho) { const int n = rho >> 4, i = rho & 15; return 8 * (i >> 2) + 4 * n + (i & 3); }

struct Unit { int pm, pn; };
struct Gemm { const bf16_t* A; const bf16_t* Bt; int M, N, K; };

struct StaticOrder {
    int nM, nN, nwg, G, c;
    __host__ __device__ void init(int M, int N, int G_, int c_) { nM = M / BM; nN = N / BM; nwg = nM * nN; G = G_; c = c_; }
    __host__ __device__ bool next(int i, Unit& u) const {
        const long L = (long)i * G + c; if (L >= nwg) return false;
        int wgid = (int)L; { const int q = nwg / NXCD, r = nwg % NXCD, xcd = wgid % NXCD, off = wgid / NXCD; wgid = (xcd < r ? xcd * (q + 1) : r * (q + 1) + (xcd - r) * q) + off; }
        const int nig = WGM * nN, gid = wgid / nig, fm = gid * WGM, gsz = (nM - fm) < WGM ? (nM - fm) : WGM;
        u.pm = fm + ((wgid % nig) % gsz); u.pn = (wgid % nig) / gsz; return true;
    }
    __device__ __forceinline__ void a_ready(const Unit&) const {}
    __device__ __forceinline__ void done(const Unit&) const {}
};

__device__ __forceinline__ unsigned cvt_pk_bf16(float lo, float hi) { unsigned r; asm volatile("v_cvt_pk_bf16_f32 %0, %1, %2" : "=v"(r) : "v"(lo), "v"(hi)); return r; }
typedef float f32x2 __attribute__((ext_vector_type(2)));
typedef unsigned u32x2 __attribute__((ext_vector_type(2)));
__device__ __forceinline__ float bf_lo(unsigned w) { return __uint_as_float(w << 16); }
__device__ __forceinline__ float bf_hi(unsigned w) { return __uint_as_float(w & 0xffff0000u); }
__device__ __forceinline__ float sigmoid_f(float x) { return __builtin_amdgcn_rcpf(1.0f + __builtin_amdgcn_exp2f(-1.4426950408889634f * x)); }
__device__ __forceinline__ float silu_f(float x) { return x * sigmoid_f(x); }
__device__ __forceinline__ u32x4 pack8(const f32x4 v0, const f32x4 v1) { u32x4 w; w.x = cvt_pk_bf16(v0[0], v0[1]); w.y = cvt_pk_bf16(v0[2], v0[3]); w.z = cvt_pk_bf16(v1[0], v1[1]); w.w = cvt_pk_bf16(v1[2], v1[3]); return w; }

struct EpiF32 {
    static constexpr bool PERM = false, AFTER_DRAIN = false;
    float* C; int ldc;
    __device__ __forceinline__ void operator()(const f32x4 (&acc)[2][2][4][2], const Unit& u, int wr, int wc, int fr, int fq) const {
        const int row0 = u.pm * BM + wr * 64 + fr, col0 = u.pn * BM + wc * 32 + 4 * fq;
#pragma unroll
        for (int ai = 0; ai < 2; ++ai)
#pragma unroll
            for (int m = 0; m < 4; ++m) { float* rowp = C + (size_t)(row0 + ai * HALF + m * 16) * ldc + col0;
#pragma unroll
                for (int bj = 0; bj < 2; ++bj)
#pragma unroll
                    for (int n = 0; n < 2; ++n) *(f32x4*)(rowp + bj * HALF + n * 16) = acc[ai][bj][m][n]; }
    }
};
struct EpiSwiGLU {
    static constexpr bool PERM = true, AFTER_DRAIN = false;
    bf16_t* O; int ldc;
    __device__ __forceinline__ void operator()(const f32x4 (&acc)[2][2][4][2], const Unit& u, int wr, int wc, int fr, int fq) const {
        const int row0 = u.pm * BM + wr * 64 + fr, col0 = u.pn * HALF + wc * 32 + 8 * fq;
#pragma unroll
        for (int ai = 0; ai < 2; ++ai)
#pragma unroll
            for (int m = 0; m < 4; ++m) { bf16_t* rowp = O + (size_t)(row0 + ai * HALF + m * 16) * ldc + col0;
                f32x4 v0, v1;
#pragma unroll
                for (int j = 0; j < 4; ++j) { v0[j] = silu_f(acc[ai][0][m][0][j]) * acc[ai][1][m][0][j]; v1[j] = silu_f(acc[ai][0][m][1][j]) * acc[ai][1][m][1][j]; }
                *(u32x4*)rowp = pack8(v0, v1); }
    }
};
template <class Op> struct EpiRow8 {
    static constexpr bool PERM = true, AFTER_DRAIN = false;
    Op op;
    __device__ __forceinline__ void operator()(const f32x4 (&acc)[2][2][4][2], const Unit& u, int wr, int wc, int fr, int fq) const {
        const int row0 = u.pm * BM + wr * 64 + fr, tc0 = wc * 32 + 8 * fq;
#pragma unroll
        for (int ai = 0; ai < 2; ++ai)
#pragma unroll
            for (int m = 0; m < 4; ++m)
#pragma unroll
                for (int bj = 0; bj < 2; ++bj) op.st(row0 + ai * HALF + m * 16, tc0 + bj * HALF, u, acc[ai][bj][m][0], acc[ai][bj][m][1]);
    }
};
struct OpQKV { bf16_t* Q; size_t stride; float qscale;
    __device__ __forceinline__ void st(int row, int tc, const Unit& u, f32x4 v0, f32x4 v1) const {
        const int t = u.pn >> 2, col = (u.pn & 3) * BM + tc; const float sc = (t == 0) ? qscale : 1.0f;
        *(u32x4*)(Q + (size_t)t * stride + (size_t)row * 1024 + col) = pack8(v0 * sc, v1 * sc); } };
struct OpZX { bf16_t* Z; bf16_t* XBC;
    __device__ __forceinline__ void st(int row, int tc, const Unit& u, f32x4 v0, f32x4 v1) const {
        if (u.pn < 8) {
#pragma unroll
            for (int j = 0; j < 4; ++j) { v0[j] = silu_f(v0[j]); v1[j] = silu_f(v1[j]); }
            *(u32x4*)(Z + (size_t)row * 2048 + u.pn * BM + tc) = pack8(v0, v1);
        } else *(u32x4*)(XBC + (size_t)row * 3072 + (u.pn - 8) * BM + tc) = pack8(v0, v1); } };
struct OpGate { bf16_t* G; const float* bias;
    __device__ __forceinline__ void st(int row, int tc, const Unit& u, f32x4 v0, f32x4 v1) const {
        const int col = u.pn * BM + tc; const f32x4 b0 = *(const f32x4*)(bias + col), b1 = *(const f32x4*)(bias + col + 4);
#pragma unroll
        for (int j = 0; j < 4; ++j) { v0[j] = sigmoid_f(v0[j] + b0[j]); v1[j] = sigmoid_f(v1[j] + b1[j]); }
        *(u32x4*)(G + (size_t)row * 2048 + col) = pack8(v0, v1); } };
template <bool FIRST> struct OpMerge { bf16_t* Mg; const bf16_t* G;
    __device__ __forceinline__ void st(int row, int tc, const Unit& u, f32x4 v0, f32x4 v1) const {
        const int col = u.pn * BM + tc; const u32x4 g = *(const u32x4*)(G + (size_t)row * 2048 + (FIRST ? 0 : 1024) + col);
        v0[0] *= bf_lo(g.x); v0[1] *= bf_hi(g.x); v0[2] *= bf_lo(g.y); v0[3] *= bf_hi(g.y); v1[0] *= bf_lo(g.z); v1[1] *= bf_hi(g.z); v1[2] *= bf_lo(g.w); v1[3] *= bf_hi(g.w);
        bf16_t* p = Mg + (size_t)row * 1024 + col;
        if (!FIRST) { const u32x4 o = *(const u32x4*)p;
            v0[0] += bf_lo(o.x); v0[1] += bf_hi(o.x); v0[2] += bf_lo(o.y); v0[3] += bf_hi(o.y); v1[0] += bf_lo(o.z); v1[1] += bf_hi(o.z); v1[2] += bf_lo(o.w); v1[3] += bf_hi(o.w); }
        *(u32x4*)p = pack8(v0, v1); } };
template <class Epi, class Sched, bool ALIGN_EPI = false, bool SP2 = false>
__device__ __forceinline__ void gemm_phase(PG8_LAS unsigned char* lds, const Gemm g, const Sched& S, const Epi& E) {
    const int tid = threadIdx.x, wid = __builtin_amdgcn_readfirstlane(tid >> 6), lane = tid & 63, wr = wid >> 2, wc = wid & 3, fr = lane & 15, fq = lane >> 4;
    const int K = g.K, nt = K / BK;
    unsigned voffA[2], voffB[2];
#pragma unroll
    for (int i = 0; i < 2; ++i) { int R, C; stage_rc(tid * 16 + i * 8192, R, C); const int Rb = Epi::PERM ? ((R & ~31) + perm32(R & 31)) : R;
        voffA[i] = (unsigned)(R * K + C) * 2u; voffB[i] = (unsigned)(Rb * K + C) * 2u; }
    const size_t kstep = (size_t)(BK * 2);
    const size_t hstep = (size_t)HALF * K * 2;
    const size_t tstep = 2 * hstep;
    const unsigned ldsw = (unsigned)wid * 1024u;
    const int aoff = lds_byte(wr * 64 + fr, fq * 8), boff = lds_byte(wc * 32 + fr, fq * 8);
#define PG8_SA(b, h) (((b) * 2 + (h)) * HTB)
#define PG8_SB(b, h) ((4 + (b) * 2 + (h)) * HTB)
#define PG8_STAGE(bufoff, gbase, voff) do { _Pragma("unroll") for (int _i = 0; _i < 2; ++_i) \
        __builtin_amdgcn_global_load_lds((const unsigned*)((const char*)(gbase) + (voff)[_i]), (PG8_LAS unsigned*)(lds + (bufoff) + ldsw + _i * 8192), 16, 0, 0); } while (0)
#define PG8_LDA(dst, b, h) do { _Pragma("unroll") for (int m = 0; m < 4; ++m) _Pragma("unroll") for (int k = 0; k < 2; ++k) dst[m][k] = *(const PG8_LAS bf16x8*)(lds + PG8_SA(b, h) + aoff + m * 2048 + k * 1024); } while (0)
#define PG8_LDB(dst, b, h) do { _Pragma("unroll") for (int n = 0; n < 2; ++n) _Pragma("unroll") for (int k = 0; k < 2; ++k) dst[n][k] = *(const PG8_LAS bf16x8*)(lds + PG8_SB(b, h) + boff + n * 2048 + k * 1024); } while (0)
#define PG8_MMA(ai, bj, At, Bt) do { __builtin_amdgcn_s_setprio(1); _Pragma("unroll") for (int m = 0; m < 4; ++m) _Pragma("unroll") for (int n = 0; n < 2; ++n) _Pragma("unroll") for (int k = 0; k < 2; ++k) \
        acc[ai][bj][m][n] = __builtin_amdgcn_mfma_f32_16x16x32_bf16(Bt[n][k], At[m][k], acc[ai][bj][m][n], 0, 0, 0); __builtin_amdgcn_s_setprio(0); } while (0)
#define PG8_WAIT_V(n) asm volatile("s_waitcnt vmcnt(" #n ")" ::: "memory")
#define PG8_WAIT_L(n) asm volatile("s_waitcnt lgkmcnt(" #n ")" ::: "memory")
#define PG8_BAR __builtin_amdgcn_s_barrier()
#define PG8_SCHED __builtin_amdgcn_sched_barrier(0)
    Unit cur, nxt; int ui = 0;
    if (!S.next(0, cur)) return;
    f32x4 acc[2][2][4][2];
#pragma unroll
    for (int a = 0; a < 2; ++a)
#pragma unroll
        for (int b = 0; b < 2; ++b)
#pragma unroll
            for (int m = 0; m < 4; ++m)
#pragma unroll
                for (int n = 0; n < 2; ++n) acc[a][b][m][n] = (f32x4){0.f, 0.f, 0.f, 0.f};
    bf16x8 At[4][2], B0[2][2], B1[2][2];
    const char* cA = (const char*)g.A + (size_t)cur.pm * tstep; const char* cB = (const char*)g.Bt + (size_t)cur.pn * tstep;
    S.a_ready(cur);
    if constexpr (SP2) {
        PG8_STAGE(PG8_SB(0, 0), cB, voffB); PG8_STAGE(PG8_SB(0, 1), cB + hstep, voffB); PG8_STAGE(PG8_SA(0, 0), cA, voffA); PG8_STAGE(PG8_SA(0, 1), cA + hstep, voffA);
        if (wr == 1) PG8_BAR;
        PG8_WAIT_V(2); PG8_BAR;
        PG8_STAGE(PG8_SB(1, 0), cB + kstep, voffB); PG8_STAGE(PG8_SA(1, 0), cA + kstep, voffA); PG8_STAGE(PG8_SB(1, 1), cB + hstep + kstep, voffB);
        PG8_WAIT_V(6); PG8_BAR;
    } else {
        PG8_STAGE(PG8_SB(0, 0), cB, voffB); PG8_STAGE(PG8_SA(0, 0), cA, voffA); PG8_STAGE(PG8_SB(0, 1), cB + hstep, voffB); PG8_STAGE(PG8_SA(0, 1), cA + hstep, voffA);
        if (wr == 1) PG8_BAR;
        PG8_WAIT_V(4); PG8_BAR;
        PG8_STAGE(PG8_SB(1, 0), cB + kstep, voffB); PG8_STAGE(PG8_SA(1, 0), cA + kstep, voffA); PG8_STAGE(PG8_SB(1, 1), cB + hstep + kstep, voffB);
        PG8_WAIT_V(6); PG8_BAR;
    }
    for (;;) {
        const bool has_next = S.next(ui + 1, nxt);
        const char* nA = has_next ? (const char*)g.A + (size_t)nxt.pm * tstep : cA; const char* nB = has_next ? (const char*)g.Bt + (size_t)nxt.pn * tstep : cB;
        for (int t = 0; t < nt; t += 2) {
            const bool last = (t == nt - 2);
            const char* a1 = cA + (size_t)(t + 1) * kstep;
            const char* a2 = last ? nA : cA + (size_t)(t + 2) * kstep; const char* b2 = last ? nB : cB + (size_t)(t + 2) * kstep;
            const char* a3 = a2 + kstep; const char* b3 = b2 + kstep;
            if (last && has_next) S.a_ready(nxt);
            if constexpr (SP2) {
            PG8_LDB(B0, 0, 0); PG8_LDB(B1, 0, 1); PG8_SCHED; PG8_LDA(At, 0, 0); PG8_STAGE(PG8_SA(1, 1), a1 + hstep, voffA);
            PG8_WAIT_V(8); PG8_WAIT_L(0); PG8_BAR; PG8_MMA(0, 0, At, B0); PG8_MMA(0, 1, At, B1); PG8_BAR; PG8_SCHED;
            PG8_LDA(At, 0, 1); PG8_STAGE(PG8_SB(0, 0), b2, voffB); PG8_STAGE(PG8_SB(0, 1), b2 + hstep, voffB); PG8_STAGE(PG8_SA(0, 0), a2, voffA);
            PG8_WAIT_V(8); PG8_WAIT_L(0); PG8_BAR; PG8_MMA(1, 0, At, B0); PG8_MMA(1, 1, At, B1); PG8_BAR; PG8_SCHED;
            PG8_LDB(B0, 1, 0); PG8_LDB(B1, 1, 1); PG8_SCHED; PG8_LDA(At, 1, 0); PG8_STAGE(PG8_SA(0, 1), a2 + hstep, voffA);
            PG8_WAIT_V(8); PG8_WAIT_L(0); PG8_BAR; PG8_MMA(0, 0, At, B0); PG8_MMA(0, 1, At, B1); PG8_BAR; PG8_SCHED;
            PG8_LDA(At, 1, 1); PG8_STAGE(PG8_SB(1, 0), b3, voffB); PG8_STAGE(PG8_SB(1, 1), b3 + hstep, voffB); PG8_STAGE(PG8_SA(1, 0), a3, voffA);
            PG8_WAIT_V(8); PG8_WAIT_L(0); PG8_BAR; PG8_MMA(1, 0, At, B0); PG8_MMA(1, 1, At, B1); PG8_BAR; PG8_SCHED;
            } else {
            PG8_LDB(B0, 0, 0); PG8_SCHED; PG8_LDA(At, 0, 0); PG8_STAGE(PG8_SA(1, 1), a1 + hstep, voffA);
            PG8_WAIT_L(8); PG8_BAR; PG8_WAIT_L(0); PG8_MMA(0, 0, At, B0); PG8_BAR; PG8_SCHED;
            PG8_LDB(B1, 0, 1); PG8_STAGE(PG8_SB(0, 0), b2, voffB);
            PG8_BAR; PG8_WAIT_L(0); PG8_MMA(0, 1, At, B1); PG8_BAR;
            PG8_LDA(At, 0, 1); PG8_STAGE(PG8_SA(0, 0), a2, voffA);
            PG8_BAR; PG8_WAIT_L(0); PG8_MMA(1, 0, At, B0); PG8_BAR; PG8_SCHED;
            PG8_STAGE(PG8_SB(0, 1), b2 + hstep, voffB);
            PG8_WAIT_V(6); PG8_BAR; PG8_MMA(1, 1, At, B1); PG8_BAR;
            PG8_LDB(B0, 1, 0); PG8_SCHED; PG8_LDA(At, 1, 0); PG8_STAGE(PG8_SA(0, 1), a2 + hstep, voffA);
            PG8_WAIT_L(8); PG8_BAR; PG8_WAIT_L(0); PG8_MMA(0, 0, At, B0); PG8_BAR; PG8_SCHED;
            PG8_LDB(B1, 1, 1); PG8_STAGE(PG8_SB(1, 0), b3, voffB);
            PG8_BAR; PG8_WAIT_L(0); PG8_MMA(0, 1, At, B1); PG8_BAR;
            PG8_LDA(At, 1, 1); PG8_STAGE(PG8_SA(1, 0), a3, voffA);
            PG8_BAR; PG8_WAIT_L(0); PG8_MMA(1, 0, At, B0); PG8_BAR; PG8_SCHED;
            PG8_STAGE(PG8_SB(1, 1), b3 + hstep, voffB);
            PG8_WAIT_V(6); PG8_BAR; PG8_MMA(1, 1, At, B1); PG8_BAR;
            }
        }
        if constexpr (ALIGN_EPI) { if (wr == 0) PG8_BAR; }
        if constexpr (!Epi::AFTER_DRAIN) { E(acc, cur, wr, wc, fr, fq); S.done(cur); }
        if (!has_next) break;
#pragma unroll
        for (int a = 0; a < 2; ++a)
#pragma unroll
            for (int b = 0; b < 2; ++b)
#pragma unroll
                for (int m = 0; m < 4; ++m)
#pragma unroll
                    for (int n = 0; n < 2; ++n) acc[a][b][m][n] = (f32x4){0.f, 0.f, 0.f, 0.f};
        cur = nxt; cA = nA; cB = nB; ++ui;
        if constexpr (ALIGN_EPI) { if (wr == 1) PG8_BAR; }
    }
    PG8_WAIT_V(0);
    if constexpr (!ALIGN_EPI) { if (wr == 0) PG8_BAR; }
    PG8_BAR;
    if constexpr (Epi::AFTER_DRAIN) { E.fused(acc, cur, wr, wc, fr, fq, lds, wid, lane); S.done(cur); }
#undef PG8_SA
#undef PG8_SB
#undef PG8_STAGE
#undef PG8_LDA
#undef PG8_LDB
#undef PG8_MMA
#undef PG8_WAIT_V
#undef PG8_WAIT_L
#undef PG8_BAR
#undef PG8_SCHED
}
}
#define GAS __attribute__((address_space(1)))
#define LAS __attribute__((address_space(3)))
typedef unsigned short bf16;
typedef unsigned v4u __attribute__((ext_vector_type(4)));
typedef float f32x4 __attribute__((ext_vector_type(4)));
typedef short bf16x8 __attribute__((ext_vector_type(8)));
typedef GAS unsigned gu32;
typedef GAS unsigned long long gu64;
#define RLX_AGENT __ATOMIC_RELAXED, __HIP_MEMORY_SCOPE_AGENT
#define LDS_WAIT() asm volatile("s_waitcnt lgkmcnt(0)" ::: "memory")
#define VM_WAIT() asm volatile("s_waitcnt vmcnt(0)" ::: "memory")
__device__ __forceinline__ unsigned long long rt() { return __builtin_amdgcn_s_memrealtime(); }
__device__ __forceinline__ unsigned f2bf(float f) { unsigned u = __builtin_bit_cast(unsigned, f); return (u + 0x7fffu + ((u >> 16) & 1u)) >> 16; }
__device__ __forceinline__ unsigned pk2(float lo, float hi) { return f2bf(lo) | (f2bf(hi) << 16); }

#define XB_TMO      128
#define XB_XCNT(j)  (256  + 64 * (j))
#define XB_XSUB(j)  (1280 + 64 * (j))
#define XB_XGEN(j)  (2304 + 64 * (j))
#define XB_TOP      3328
#define XB_TOPGEN   3392
#define XCD_BAR_WORDS 3456
#define XB_SPIN_CAP (1u << 18)

__device__ __forceinline__ unsigned xb_ld(unsigned* p)              { return __hip_atomic_load(p, __ATOMIC_RELAXED, __HIP_MEMORY_SCOPE_AGENT); }
__device__ __forceinline__ unsigned xb_add(unsigned* p, unsigned v) { return __hip_atomic_fetch_add(p, v, __ATOMIC_RELAXED, __HIP_MEMORY_SCOPE_AGENT); }
__device__ __forceinline__ unsigned xb_xcc_id() { return (unsigned)__builtin_amdgcn_s_getreg((3 << 11) | 20) & 0xFu; }
#define XB_SPIN(cond, bar) do { unsigned _sp = 0; while (cond) { __builtin_amdgcn_s_sleep(1); \
    if ((++_sp & 255u) == 0u) { if (xb_ld(&(bar)[XB_TMO])) break; if (_sp > XB_SPIN_CAP) { atomicAdd(&(bar)[XB_TMO], 1u); break; } } } } while (0)

struct XcdBarrier {
    unsigned* bar; unsigned x;
    volatile LAS unsigned* st;
};

__device__ __forceinline__ XcdBarrier xcd_barrier_post(unsigned* bar, volatile LAS unsigned* st) {
    XcdBarrier b; b.bar = bar; b.x = xb_xcc_id(); b.st = st;
    if (threadIdx.x == 0) (void)xb_add(&bar[XB_XCNT(b.x)], 1u);
    return b;
}
__device__ __forceinline__ void xcd_barrier_complete(unsigned* bar, unsigned x, unsigned& nloc, unsigned& nx) {
    const unsigned G = gridDim.x * gridDim.y * gridDim.z;
    unsigned sum, cnt, mine, sp = 0u;
    for (;;) {
        sum = 0u; cnt = 0u; mine = 0u;
#pragma unroll
        for (unsigned j = 0; j < 16; ++j) { const unsigned c = xb_ld(&bar[XB_XCNT(j)]); sum += c; cnt += (c > 0u) ? 1u : 0u; mine = (j == x) ? c : mine; }
        if (sum == G) break;
        __builtin_amdgcn_s_sleep(1);
        if ((++sp & 255u) == 0u) { if (xb_ld(&bar[XB_TMO])) break; if (sp > XB_SPIN_CAP) { atomicAdd(&bar[XB_TMO], 1u); break; } }
    }
    nloc = mine > 0u ? mine : 1u; nx = cnt > 0u ? cnt : 1u;
}

__device__ __forceinline__ void xcd_barrier(const XcdBarrier& b) {
    asm volatile("s_waitcnt vmcnt(0)" ::: "memory");
    __syncthreads();
    if (threadIdx.x == 0) {
        unsigned* bar = b.bar;
        __builtin_amdgcn_s_waitcnt(0);
        unsigned nloc = b.st[0], nx = b.st[1];
        if (nloc == 0u) { xcd_barrier_complete(bar, b.x, nloc, nx); b.st[0] = nloc; b.st[1] = nx; }
        const unsigned old = xb_add(&bar[XB_XSUB(b.x)], 1u);
        const unsigned gen = old / nloc;
        if (old + 1u == (gen + 1u) * nloc) {
            __builtin_amdgcn_fence(__ATOMIC_RELEASE, "agent");
            asm volatile("s_waitcnt vmcnt(0)" ::: "memory");
            const unsigned og = xb_add(&bar[XB_TOP], 1u);
            const unsigned tg = og / nx;
            if (og + 1u == (tg + 1u) * nx) xb_add(&bar[XB_TOPGEN], 1u);
            else XB_SPIN(xb_ld(&bar[XB_TOPGEN]) == tg, bar);
            __builtin_amdgcn_fence(__ATOMIC_ACQUIRE, "agent");
            xb_add(&bar[XB_XGEN(b.x)], 1u);
            asm volatile("s_waitcnt vmcnt(0)" ::: "memory");
        } else {
            XB_SPIN(xb_ld(&bar[XB_XGEN(b.x)]) == gen, bar);
            __builtin_amdgcn_fence(__ATOMIC_ACQUIRE, "agent");
            asm volatile("s_waitcnt vmcnt(0)" ::: "memory");
        }
    }
    __syncthreads();
}

constexpr int NWAVES = 8, NTHR = NWAVES * 64;
constexpr int BATCH = 8, SEQ = 2048, D = 1024, M = BATCH * SEQ, FF = 2816, NIN = 10272;
constexpr int SSD_INNER = 2048, SSD_H = 32, SSD_P = 64, SSD_N = 128, CONV_CH = 3072;
constexpr int DA_H = 8;
constexpr float EPS = 1e-6f, LOG2E = 1.4426950408889634f;
constexpr float QSCALE = 0.125f * LOG2E;
constexpr float LAM_INIT = 0.2f;
constexpr int NPH = 18;
enum { I_X = 0, I_F1_PRE, I_F1_WG, I_F1_WU, I_F1_WD, I_F1_POST, I_MIX_PRE, I_WIN, I_GATE_B, I_CONV_W, I_CONV_B, I_DT_BIAS, I_A_LOG, I_SSD_D, I_SSD_NORM, I_SSD_W,
       I_LQ1, I_LK1, I_LQ2, I_LK2, I_SUBLN, I_DA_W, I_WOUT, I_MIX_POST, I_F2_PRE, I_F2_WG, I_F2_WU, I_F2_WD, I_F2_POST, N_INPUTS };

constexpr size_t MiB = 1u << 20;
constexpr size_t WS_CTL = 0, CTL_ZERO_BYTES = 1 * MiB;
constexpr size_t WS_WGU = 1 * MiB, WS_WD = 12 * MiB, WS_WQKV = 18 * MiB, WS_WZX = 24 * MiB, WS_WGATE = 34 * MiB, WS_WSSD = 38 * MiB, WS_WDA = 42 * MiB, WS_WOUT = 44 * MiB, WS_WDT = 46 * MiB;
constexpr size_t WS_F1N = 48 * MiB, WS_XN = 80 * MiB;
constexpr size_t WS_H = 112 * MiB;
constexpr size_t WS_Q = 112 * MiB, WS_K = 144 * MiB, WS_V = 176 * MiB;
constexpr size_t WS_AN = 112 * MiB;
constexpr size_t WS_XBC = 144 * MiB;
constexpr size_t WS_DT = 240 * MiB, WS_SSQP = 242 * MiB;
constexpr size_t WS_GATES = 144 * MiB, WS_MERGED = 208 * MiB;
constexpr size_t WS_TMP = 48 * MiB;
constexpr size_t WS_END = 256 * MiB;
constexpr int CW_TMO = 0, CW_CODE = 1, CW_BAR = 4096;

constexpr int RING_OFF = 0, RING_BYTES = 131072;
constexpr int LDSCTL_OFF = RING_BYTES, MISC_OFF = LDSCTL_OFF + 320;
constexpr int LDS_BYTES = 147456;

struct Args { const float* in[N_INPUTS]; float* out; unsigned char* ws; int ph_lo, ph_hi; int pad0, pad1; };
static_assert(sizeof(Args) == N_INPUTS * 8 + 8 + 8 + 16, "Args has no padding holes");

struct Ctx { LAS unsigned char* lds; int tid, lane, wave, vcu, G; };

__device__ __forceinline__ float wave_sum(float v) {
#pragma unroll
    for (int o = 1; o < 64; o <<= 1) v += __shfl_xor(v, o);
    return v;
}
__device__ __forceinline__ float bflo(unsigned w) { return __uint_as_float(w << 16); }
__device__ __forceinline__ float bfhi(unsigned w) { return __uint_as_float(w & 0xffff0000u); }
__device__ __forceinline__ float bf1(bf16 h) { return __uint_as_float((unsigned)h << 16); }
__device__ __forceinline__ float sigm(float x) { return 1.0f / (1.0f + __expf(-x)); }

__device__ __forceinline__ void transpose_item(const float* W, int ldw, int K, bf16* WT, int dst_row0, int k0, int n0, LAS float* scr, int lane) {
#pragma unroll 8
    for (int i = 0; i < 32; ++i) { const int kk = 2 * i + (lane >> 5); scr[kk * 33 + (lane & 31)] = W[(size_t)(k0 + kk) * ldw + n0 + (lane & 31)]; }
    LDS_WAIT(); asm volatile("" ::: "memory");
    const int c = lane & 7;
#pragma unroll
    for (int j = 0; j < 4; ++j) { const int n = (lane >> 3) + 8 * j; const LAS float* s = scr + (8 * c) * 33 + n;
        v4u o; o.x = pk2(s[0 * 33], s[1 * 33]); o.y = pk2(s[2 * 33], s[3 * 33]); o.z = pk2(s[4 * 33], s[5 * 33]); o.w = pk2(s[6 * 33], s[7 * 33]);
        *(GAS v4u*)(WT + (size_t)(dst_row0 + n) * K + k0 + 8 * c) = o; }
    LDS_WAIT(); asm volatile("" ::: "memory");
}
constexpr int FFN_ITEMS = 3 * 16 * 88;
__device__ __forceinline__ void ffn_weight_item(const float* wg, const float* wu, const float* wd, unsigned char* ws, int it, LAS float* scr, int lane) {
    bf16* WGU = (bf16*)(ws + WS_WGU); bf16* WD = (bf16*)(ws + WS_WD);
    if (it < 2 * 1408) { const bool up = it >= 1408; const int r = up ? it - 1408 : it; const int kb = r / 88, nb = r % 88, n0 = nb * 32;
        transpose_item(up ? wu : wg, FF, D, WGU, 256 * (n0 >> 7) + (up ? 128 : 0) + (n0 & 127), kb * 64, n0, scr, lane); }
    else { const int r = it - 2 * 1408; const int kb = r / 32, nb = r % 32;
        transpose_item(wd, D, FF, WD, nb * 32, kb * 64, nb * 32, scr, lane); }
}
constexpr int WIN_ITEMS = 16 * 321, WSSD_ITEMS = 32 * 32, WSQ_ITEMS = 16 * 32;
__device__ __forceinline__ void mixer_weight_item(const Args& a, int it, LAS float* scr, int lane) {
    unsigned char* ws = a.ws;
    if (it < WIN_ITEMS) { const int kb = it / 321, nb = it % 321, n0 = nb * 32; bf16* dst; int row;
        if (n0 < 5120) { dst = (bf16*)(ws + WS_WZX); row = n0; }
        else if (n0 < 5152) { dst = (bf16*)(ws + WS_WDT); row = n0 - 5120; }
        else if (n0 < 8224) { dst = (bf16*)(ws + WS_WQKV); row = n0 - 5152; }
        else { dst = (bf16*)(ws + WS_WGATE); row = n0 - 8224; }
        transpose_item(a.in[I_WIN], NIN, D, dst, row, kb * 64, n0, scr, lane); return; }
    it -= WIN_ITEMS;
    if (it < WSSD_ITEMS) { const int kb = it / 32, nb = it % 32; transpose_item(a.in[I_SSD_W], D, SSD_INNER, (bf16*)(ws + WS_WSSD), nb * 32, kb * 64, nb * 32, scr, lane); return; }
    it -= WSSD_ITEMS;
    if (it < WSQ_ITEMS) { const int kb = it / 32, nb = it % 32; transpose_item(a.in[I_DA_W], D, D, (bf16*)(ws + WS_WDA), nb * 32, kb * 64, nb * 32, scr, lane); return; }
    it -= WSQ_ITEMS;
    { const int kb = it / 32, nb = it % 32; transpose_item(a.in[I_WOUT], D, D, (bf16*)(ws + WS_WOUT), nb * 32, kb * 64, nb * 32, scr, lane); }
}
constexpr int MIXER_ITEMS = WIN_ITEMS + WSSD_ITEMS + 2 * WSQ_ITEMS;

__device__ __forceinline__ void row_load(const float* row, int lane, f32x4 (&v)[4]) {
    const GAS f32x4* p = (const GAS f32x4*)row + lane;
#pragma unroll
    for (int j = 0; j < 4; ++j) v[j] = p[64 * j];
}
__device__ __forceinline__ void row_store(float* row, int lane, const f32x4 (&v)[4]) {
    GAS f32x4* p = (GAS f32x4*)row + lane;
#pragma unroll
    for (int j = 0; j < 4; ++j) p[64 * j] = v[j];
}
__device__ __forceinline__ void row_load_bf(const bf16* row, int lane, f32x4 (&v)[4]) {
    const GAS unsigned long long* p = (const GAS unsigned long long*)row + lane;
#pragma unroll
    for (int j = 0; j < 4; ++j) { const unsigned long long w = p[64 * j]; const unsigned lo = (unsigned)w, hi = (unsigned)(w >> 32); v[j] = (f32x4){bflo(lo), bfhi(lo), bflo(hi), bfhi(hi)}; }
}
__device__ __forceinline__ void row_store_bf_round(bf16* row, int lane, f32x4 (&v)[4]) {
    GAS unsigned long long* p = (GAS unsigned long long*)row + lane;
#pragma unroll
    for (int j = 0; j < 4; ++j) { const unsigned lo = pk2(v[j].x, v[j].y), hi = pk2(v[j].z, v[j].w); p[64 * j] = (unsigned long long)lo | ((unsigned long long)hi << 32);
        v[j] = (f32x4){bflo(lo), bfhi(lo), bflo(hi), bfhi(hi)}; }
}
__device__ __forceinline__ float row_rstd(const f32x4 (&v)[4]) {
    float s = 0.f;
#pragma unroll
    for (int j = 0; j < 4; ++j) s += (v[j].x * v[j].x + v[j].y * v[j].y) + (v[j].z * v[j].z + v[j].w * v[j].w);
    return 1.0f / sqrtf(wave_sum(s) * (1.0f / D) + EPS);
}
__device__ __forceinline__ void row_scale_gain(f32x4 (&v)[4], float s, const float* g, int lane) {
    const GAS f32x4* p = (const GAS f32x4*)g + lane;
#pragma unroll
    for (int j = 0; j < 4; ++j) v[j] = v[j] * s * p[64 * j];
}

__device__ __forceinline__ void ph_prologue(const Args& a, const Ctx& c) {
    LAS float* scr = (LAS float*)(c.lds + RING_OFF + c.wave * 16384);
    const int gw = c.vcu * NWAVES + c.wave, NGW = c.G * NWAVES;
    for (int it = gw; it < FFN_ITEMS + MIXER_ITEMS; it += NGW) {
        if (it < FFN_ITEMS) ffn_weight_item(a.in[I_F1_WG], a.in[I_F1_WU], a.in[I_F1_WD], a.ws, it, scr, c.lane);
        else mixer_weight_item(a, it - FFN_ITEMS, scr, c.lane);
    }
    bf16* XN = (bf16*)(a.ws + WS_XN);
    for (int m = gw; m < M; m += NGW) { f32x4 v[4]; row_load(a.in[I_X] + (size_t)m * D, c.lane, v); const float r = row_rstd(v); row_scale_gain(v, r, a.in[I_F1_PRE], c.lane); row_store_bf_round(XN + (size_t)m * D, c.lane, v); }
}
__device__ __forceinline__ void ph_e2(const Args& a, const Ctx& c) {
    const int gw = c.vcu * NWAVES + c.wave, NGW = c.G * NWAVES; bf16* XN = (bf16*)(a.ws + WS_XN); bf16* F1N = (bf16*)(a.ws + WS_F1N);
    for (int m = gw; m < M; m += NGW) { f32x4 v[4], x[4]; row_load(a.out + (size_t)m * D, c.lane, v); row_load(a.in[I_X] + (size_t)m * D, c.lane, x);
        const float r = row_rstd(v); row_scale_gain(v, 0.5f * r, a.in[I_F1_POST], c.lane); row_store_bf_round(F1N + (size_t)m * D, c.lane, v);
#pragma unroll
        for (int j = 0; j < 4; ++j) v[j] = v[j] + x[j];
        const float r2 = row_rstd(v); row_scale_gain(v, r2, a.in[I_MIX_PRE], c.lane); row_store_bf_round(XN + (size_t)m * D, c.lane, v); }
}
__device__ __forceinline__ void ph_e8(const Args& a, const Ctx& c) {
    const int gw = c.vcu * NWAVES + c.wave, NGW = c.G * NWAVES; bf16* XN = (bf16*)(a.ws + WS_XN); const bf16* F1N = (const bf16*)(a.ws + WS_F1N);
    for (int m = gw; m < M; m += NGW) { f32x4 v[4], x[4], f[4]; row_load(a.out + (size_t)m * D, c.lane, v); row_load(a.in[I_X] + (size_t)m * D, c.lane, x); row_load_bf(F1N + (size_t)m * D, c.lane, f);
        const float r = row_rstd(v); row_scale_gain(v, r, a.in[I_MIX_POST], c.lane);
#pragma unroll
        for (int j = 0; j < 4; ++j) v[j] = v[j] + x[j] + f[j];
        row_store(a.out + (size_t)m * D, c.lane, v);
        const float r2 = row_rstd(v); row_scale_gain(v, r2, a.in[I_F2_PRE], c.lane); row_store_bf_round(XN + (size_t)m * D, c.lane, v); }
}
__device__ __forceinline__ void ph_e10(const Args& a, const Ctx& c) {
    const int gw = c.vcu * NWAVES + c.wave, NGW = c.G * NWAVES; const float* TMP = (const float*)(a.ws + WS_TMP);
    for (int m = gw; m < M; m += NGW) { f32x4 v[4], h[4]; row_load(TMP + (size_t)m * D, c.lane, v); row_load(a.out + (size_t)m * D, c.lane, h);
        const float r = row_rstd(v); row_scale_gain(v, 0.5f * r, a.in[I_F2_POST], c.lane);
#pragma unroll
        for (int j = 0; j < 4; ++j) v[j] = v[j] + h[j];
        row_store(a.out + (size_t)m * D, c.lane, v); }
}
__device__ __forceinline__ void ph_attn_simple(const Args& a, const Ctx& c) {
    const bf16* Q = (const bf16*)(a.ws + WS_Q); const bf16* K = (const bf16*)(a.ws + WS_K); const bf16* V = (const bf16*)(a.ws + WS_V); bf16* O = (bf16*)a.out;
    for (int item = c.vcu; item < BATCH * 32; item += c.G) {
        const int b = item >> 5, hm = (item >> 1) & 15, vh = item & 1, h = hm >> 1;
        const float sl2 = exp2f(-(float)(h + 1)) * LOG2E;
        for (int r = 0; r < 4; ++r) {
            const int qpos = c.tid + NTHR * r; const size_t qrow = (size_t)(b * SEQ + qpos);
            float q[64], o[64];
            { const GAS v4u* qp = (const GAS v4u*)(Q + qrow * 1024 + hm * 64);
#pragma unroll
              for (int i = 0; i < 8; ++i) { const v4u w = qp[i]; q[8 * i] = bflo(w.x); q[8 * i + 1] = bfhi(w.x); q[8 * i + 2] = bflo(w.y); q[8 * i + 3] = bfhi(w.y); q[8 * i + 4] = bflo(w.z); q[8 * i + 5] = bfhi(w.z); q[8 * i + 6] = bflo(w.w); q[8 * i + 7] = bfhi(w.w); } }
#pragma unroll
            for (int d = 0; d < 64; ++d) o[d] = 0.f;
            float mrun = -1e30f, l = 0.f;
            const int jmax = qpos | 63;
            for (int j = 0; j <= jmax; ++j) {
                const GAS v4u* kp = (const GAS v4u*)(K + (size_t)(b * SEQ + j) * 1024 + hm * 64);
                const GAS v4u* vp = (const GAS v4u*)(V + (size_t)(b * SEQ + j) * 1024 + h * 128 + vh * 64);
                float s = 0.f;
#pragma unroll
                for (int i = 0; i < 8; ++i) { const v4u w = kp[i]; s += q[8 * i] * bflo(w.x) + q[8 * i + 1] * bfhi(w.x) + q[8 * i + 2] * bflo(w.y) + q[8 * i + 3] * bfhi(w.y) + q[8 * i + 4] * bflo(w.z) + q[8 * i + 5] * bfhi(w.z) + q[8 * i + 6] * bflo(w.w) + q[8 * i + 7] * bfhi(w.w); }
                s += sl2 * (float)(j - qpos);
                if (j <= qpos) {
                    const float mn = fmaxf(mrun, s), al = exp2f(mrun - mn), p = exp2f(s - mn); l = l * al + p; mrun = mn;
#pragma unroll
                    for (int i = 0; i < 8; ++i) { const v4u w = vp[i];
                        o[8 * i] = o[8 * i] * al + p * bflo(w.x); o[8 * i + 1] = o[8 * i + 1] * al + p * bfhi(w.x); o[8 * i + 2] = o[8 * i + 2] * al + p * bflo(w.y); o[8 * i + 3] = o[8 * i + 3] * al + p * bfhi(w.y);
                        o[8 * i + 4] = o[8 * i + 4] * al + p * bflo(w.z); o[8 * i + 5] = o[8 * i + 5] * al + p * bfhi(w.z); o[8 * i + 6] = o[8 * i + 6] * al + p * bflo(w.w); o[8 * i + 7] = o[8 * i + 7] * al + p * bfhi(w.w); }
                }
            }
            const float rl = 1.0f / l; GAS v4u* op = (GAS v4u*)(O + qrow * 2048 + hm * 128 + vh * 64);
#pragma unroll
            for (int i = 0; i < 8; ++i) { v4u w; w.x = pk2(o[8 * i] * rl, o[8 * i + 1] * rl); w.y = pk2(o[8 * i + 2] * rl, o[8 * i + 3] * rl); w.z = pk2(o[8 * i + 4] * rl, o[8 * i + 5] * rl); w.w = pk2(o[8 * i + 6] * rl, o[8 * i + 7] * rl); op[i] = w; }
        }
    }
}
__device__ __forceinline__ void ph_attn_final(const Args& a, const Ctx& c) {
    const int gw = c.vcu * NWAVES + c.wave, NGW = c.G * NWAVES;
    { LAS float* scr = (LAS float*)(c.lds + RING_OFF + c.wave * 16384);
      for (int it = gw; it < FFN_ITEMS; it += NGW) ffn_weight_item(a.in[I_F2_WG], a.in[I_F2_WU], a.in[I_F2_WD], a.ws, it, scr, c.lane); }
    const float s1 = wave_sum(a.in[I_LQ1][c.lane] * a.in[I_LK1][c.lane]), s2 = wave_sum(a.in[I_LQ2][c.lane] * a.in[I_LK2][c.lane]);
    const float lam = __expf(s1) - __expf(s2) + LAM_INIT;
    const float g0 = a.in[I_SUBLN][2 * c.lane] * (1.0f - LAM_INIT), g1 = a.in[I_SUBLN][2 * c.lane + 1] * (1.0f - LAM_INIT);
    const bf16* O = (const bf16*)a.out; bf16* AN = (bf16*)(a.ws + WS_AN);
    for (int m = gw; m < M; m += NGW) {
        const GAS unsigned* op = (const GAS unsigned*)(O + (size_t)m * 2048) + c.lane; GAS unsigned* ap = (GAS unsigned*)(AN + (size_t)m * 1024) + c.lane;
#pragma unroll
        for (int h = 0; h < DA_H; ++h) { const unsigned w0 = op[h * 128], w1 = op[h * 128 + 64];
            const float x0 = bflo(w0) - lam * bflo(w1), x1 = bfhi(w0) - lam * bfhi(w1);
            const float r = 1.0f / sqrtf(wave_sum(x0 * x0 + x1 * x1) * (1.0f / 128.0f) + EPS);
            ap[h * 64] = pk2(x0 * r * g0, x1 * r * g1); }
    }
}
__device__ __forceinline__ void ph_dt(const Args& a, const Ctx& c) {
    const bf16* XN = (const bf16*)(a.ws + WS_XN); const bf16* WDT = (const bf16*)(a.ws + WS_WDT); float* DT = (float*)(a.ws + WS_DT);
    for (int idx = c.vcu * NTHR + c.tid; idx < M * SSD_H; idx += c.G * NTHR) {
        const int t = idx >> 5, h = idx & 31; const GAS v4u* xp = (const GAS v4u*)(XN + (size_t)t * D); const GAS v4u* wp = (const GAS v4u*)(WDT + (size_t)h * D);
        float s = 0.f;
        for (int i = 0; i < D / 8; ++i) { const v4u x = xp[i], w = wp[i];
            s += bflo(x.x) * bflo(w.x) + bfhi(x.x) * bfhi(w.x) + bflo(x.y) * bflo(w.y) + bfhi(x.y) * bfhi(w.y) + bflo(x.z) * bflo(w.z) + bfhi(x.z) * bfhi(w.z) + bflo(x.w) * bflo(w.w) + bfhi(x.w) * bfhi(w.w); }
        s += a.in[I_DT_BIAS][h];
        DT[idx] = s > 20.f ? s : log1pf(__expf(s));
    }
}
__device__ __forceinline__ void ph_ssd_simple(const Args& a, const Ctx& c) {
    bf16* Z = (bf16*)a.out; const bf16* XBC = (const bf16*)(a.ws + WS_XBC); const float* DT = (const float*)(a.ws + WS_DT); float* SSQP = (float*)(a.ws + WS_SSQP);
    LAS float* xL = (LAS float*)(c.lds); LAS float* BL = xL + 64 * 64; LAS float* CL = BL + 64 * 128; LAS float* yL = CL + 64 * 128; LAS float* dtL = yL + 64 * 64;
    const float* cw = a.in[I_CONV_W]; const float* cb = a.in[I_CONV_B];
    for (int item = c.vcu; item < BATCH * SSD_H; item += c.G) {
        const int b = item >> 5, h = item & 31, g = h >> 3;
        const float Ah = -__expf(a.in[I_A_LOG][h]), Dh = a.in[I_SSD_D][h];
        const int p = c.tid >> 3, nq = c.tid & 7;
        float st[16];
#pragma unroll
        for (int i = 0; i < 16; ++i) st[i] = 0.f;
        for (int sub = 0; sub < SEQ / 64; ++sub) {
            const int t0 = sub * 64;
            for (int idx = c.tid; idx < 64 * 320; idx += NTHR) {
                const int tl = idx / 320, ch = idx % 320;
                const int gc = ch < 64 ? h * 64 + ch : (ch < 192 ? 2048 + g * 128 + (ch - 64) : 2560 + g * 128 + (ch - 192));
                float acc = cb[gc];
#pragma unroll
                for (int j = 0; j < 4; ++j) { const int tt = t0 + tl - 3 + j; if (tt >= 0) acc += cw[j * CONV_CH + gc] * bf1(XBC[(size_t)(b * SEQ + tt) * CONV_CH + gc]); }
                const float v = acc * sigm(acc);
                if (ch < 64) xL[tl * 64 + ch] = v; else if (ch < 192) BL[tl * 128 + ch - 64] = v; else CL[tl * 128 + ch - 192] = v;
            }
            if (c.tid < 64) dtL[c.tid] = DT[(size_t)(b * SEQ + t0 + c.tid) * SSD_H + h];
            __syncthreads();
            for (int tl = 0; tl < 64; ++tl) {
                const float dtv = dtL[tl], dA = __expf(dtv * Ah), xv = xL[tl * 64 + p], coef = dtv * xv;
                const LAS f32x4* bp = (const LAS f32x4*)(BL + tl * 128 + nq * 16); const LAS f32x4* cp = (const LAS f32x4*)(CL + tl * 128 + nq * 16);
                float ys = 0.f;
#pragma unroll
                for (int i = 0; i < 4; ++i) { const f32x4 bv = bp[i], cv = cp[i];
#pragma unroll
                    for (int k = 0; k < 4; ++k) { st[4 * i + k] = st[4 * i + k] * dA + coef * bv[k]; ys += cv[k] * st[4 * i + k]; } }
                ys += __shfl_xor(ys, 1); ys += __shfl_xor(ys, 2); ys += __shfl_xor(ys, 4);
                if (nq == 0) yL[tl * 64 + p] = ys + Dh * xv;
            }
            __syncthreads();
#pragma unroll
            for (int i = 0; i < 8; ++i) { const int idx = c.tid + NTHR * i, tl = idx >> 6, pp = idx & 63; const size_t t = (size_t)(b * SEQ + t0 + tl);
                bf16* zp = Z + t * SSD_INNER + h * 64 + pp; const float yp = yL[tl * 64 + pp] * bf1(*zp); const bf16 yb = (bf16)f2bf(yp); *zp = yb;
                const float yr = bf1(yb); const float sq = wave_sum(yr * yr); if (c.lane == 0) SSQP[t * SSD_H + h] = sq; }
            __syncthreads();
        }
    }
}
__device__ __forceinline__ void ph_ssd_final(const Args& a, const Ctx& c) {
    const int gw = c.vcu * NWAVES + c.wave, NGW = c.G * NWAVES; bf16* Y = (bf16*)a.out; const float* SSQP = (const float*)(a.ws + WS_SSQP); const float* ng = a.in[I_SSD_NORM];
    for (int m = gw; m < M; m += NGW) {
#pragma unroll
        for (int g = 0; g < 4; ++g) { float ss = 0.f;
#pragma unroll
            for (int i = 0; i < 8; ++i) ss += SSQP[(size_t)m * SSD_H + g * 8 + i];
            const float r = 1.0f / sqrtf(ss * (1.0f / 512.0f) + EPS);
            GAS v4u* yp = (GAS v4u*)(Y + (size_t)m * SSD_INNER + g * 512) + c.lane; const v4u w = *yp; const GAS f32x4* gp = (const GAS f32x4*)(ng + g * 512 + 8 * c.lane); const f32x4 g0 = gp[0], g1 = gp[1];
            v4u o; o.x = pk2(bflo(w.x) * r * g0.x, bfhi(w.x) * r * g0.y); o.y = pk2(bflo(w.y) * r * g0.z, bfhi(w.y) * r * g0.w); o.z = pk2(bflo(w.z) * r * g1.x, bfhi(w.z) * r * g1.y); o.w = pk2(bflo(w.w) * r * g1.z, bfhi(w.w) * r * g1.w);
            *yp = o; }
    }
}

__global__ void __launch_bounds__(NTHR, 2) skel_fwd(Args args) {
    extern __shared__ __attribute__((aligned(16))) unsigned char lds[];
    Ctx c;
    c.lds = (LAS unsigned char*)lds;
    volatile LAS unsigned* MISC = (volatile LAS unsigned*)(c.lds + MISC_OFF);
    c.tid = threadIdx.x; c.lane = c.tid & 63; c.wave = __builtin_amdgcn_readfirstlane(c.tid >> 6);
    c.G = gridDim.x; { const int bx = blockIdx.x; c.vcu = (c.G % 8 == 0) ? (bx % 8) * (c.G / 8) + bx / 8 : bx; }
    unsigned char* ws = args.ws;
    gu32* ctl = (gu32*)(ws + WS_CTL);
    for (int u = c.tid; u < (LDS_BYTES - LDSCTL_OFF) / 4; u += NTHR) ((LAS unsigned*)(c.lds + LDSCTL_OFF))[u] = 0u;
    __syncthreads();
    const int lo = args.ph_lo, hi = args.ph_hi;
    XcdBarrier bar; bar.bar = (unsigned*)(ctl + CW_BAR); bar.x = 0; bar.st = nullptr;
    if (hi - lo > 1) bar = xcd_barrier_post((unsigned*)(ctl + CW_BAR), MISC + 8);
#define IN(k) (lo <= (k) && (k) < hi)
#define SEAM(k) do { if (IN(k) && IN((k) + 1)) xcd_barrier(bar); } while (0)
    using namespace pg8;
    LAS unsigned char* ring = c.lds + RING_OFF;
    const bf16_t* XN = (const bf16_t*)(ws + WS_XN);

    if (IN(0)) { ph_prologue(args, c); } SEAM(0);
    if (IN(1)) { Gemm g{XN, (const bf16_t*)(ws + WS_WGU), M, 2 * FF, D}; StaticOrder S; S.init(M, 2 * FF, c.G, (int)blockIdx.x); EpiSwiGLU E{(bf16_t*)(ws + WS_H), FF};
        gemm_phase<EpiSwiGLU, StaticOrder, true, true>(ring, g, S, E); } SEAM(1);
    if (IN(2)) { Gemm g{(const bf16_t*)(ws + WS_H), (const bf16_t*)(ws + WS_WD), M, D, FF}; StaticOrder S; S.init(M, D, c.G, (int)blockIdx.x); EpiF32 E{args.out, D};
        gemm_phase<EpiF32, StaticOrder, true, true>(ring, g, S, E); } SEAM(2);
    if (IN(3)) { ph_e2(args, c); } SEAM(3);
    if (IN(4)) { Gemm g{XN, (const bf16_t*)(ws + WS_WQKV), M, 3 * D, D}; StaticOrder S; S.init(M, 3 * D, c.G, (int)blockIdx.x);
        EpiRow8<OpQKV> E{{(bf16_t*)(ws + WS_Q), (WS_K - WS_Q) / 2, QSCALE}};
        gemm_phase<EpiRow8<OpQKV>, StaticOrder, true, true>(ring, g, S, E); } SEAM(4);
    if (IN(5)) { ph_attn_simple(args, c); } SEAM(5);
    if (IN(6)) { ph_attn_final(args, c); } SEAM(6);
    if (IN(7)) { Gemm g{XN, (const bf16_t*)(ws + WS_WZX), M, 5120, D}; StaticOrder S; S.init(M, 5120, c.G, (int)blockIdx.x);
        EpiRow8<OpZX> E{{(bf16_t*)args.out, (bf16_t*)(ws + WS_XBC)}};
        gemm_phase<EpiRow8<OpZX>, StaticOrder, true, true>(ring, g, S, E);
        ph_dt(args, c); } SEAM(7);
    if (IN(8)) { ph_ssd_simple(args, c); } SEAM(8);
    if (IN(9)) { ph_ssd_final(args, c); } SEAM(9);
    if (IN(10)) { Gemm g{XN, (const bf16_t*)(ws + WS_WGATE), M, 2 * D, D}; StaticOrder S; S.init(M, 2 * D, c.G, (int)blockIdx.x);
        EpiRow8<OpGate> E{{(bf16_t*)(ws + WS_GATES), args.in[I_GATE_B]}};
        gemm_phase<EpiRow8<OpGate>, StaticOrder, true, true>(ring, g, S, E); } SEAM(10);
    if (IN(11)) { Gemm g{(const bf16_t*)args.out, (const bf16_t*)(ws + WS_WSSD), M, D, SSD_INNER}; StaticOrder S; S.init(M, D, c.G, (int)blockIdx.x);
        EpiRow8<OpMerge<true>> E{{(bf16_t*)(ws + WS_MERGED), (const bf16_t*)(ws + WS_GATES)}};
        gemm_phase<EpiRow8<OpMerge<true>>, StaticOrder, true, true>(ring, g, S, E); } SEAM(11);
    if (IN(12)) { Gemm g{(const bf16_t*)(ws + WS_AN), (const bf16_t*)(ws + WS_WDA), M, D, D}; StaticOrder S; S.init(M, D, c.G, (int)blockIdx.x);
        EpiRow8<OpMerge<false>> E{{(bf16_t*)(ws + WS_MERGED), (const bf16_t*)(ws + WS_GATES)}};
        gemm_phase<EpiRow8<OpMerge<false>>, StaticOrder, true, true>(ring, g, S, E); } SEAM(12);
    if (IN(13)) { Gemm g{(const bf16_t*)(ws + WS_MERGED), (const bf16_t*)(ws + WS_WOUT), M, D, D}; StaticOrder S; S.init(M, D, c.G, (int)blockIdx.x); EpiF32 E{args.out, D};
        gemm_phase<EpiF32, StaticOrder, true, true>(ring, g, S, E); } SEAM(13);
    if (IN(14)) { ph_e8(args, c); } SEAM(14);
    if (IN(15)) { Gemm g{XN, (const bf16_t*)(ws + WS_WGU), M, 2 * FF, D}; StaticOrder S; S.init(M, 2 * FF, c.G, (int)blockIdx.x); EpiSwiGLU E{(bf16_t*)(ws + WS_H), FF};
        gemm_phase<EpiSwiGLU, StaticOrder, true, true>(ring, g, S, E); } SEAM(15);
    if (IN(16)) { Gemm g{(const bf16_t*)(ws + WS_H), (const bf16_t*)(ws + WS_WD), M, D, FF}; StaticOrder S; S.init(M, D, c.G, (int)blockIdx.x); EpiF32 E{(float*)(ws + WS_TMP), D};
        gemm_phase<EpiF32, StaticOrder, true, true>(ring, g, S, E); } SEAM(16);
    if (IN(17)) { ph_e10(args, c); }
#undef IN
#undef SEAM
}

#ifndef MK_ONE_LAUNCH
#define MK_ONE_LAUNCH 1
#endif
extern "C" void kernel_launch(void* const* d_in, const int* in_sizes, int n_in, void* d_out, int out_size, void* d_ws, size_t ws_size, hipStream_t stream) {
    static int grid = 0;
    if (grid == 0) {
        if (n_in != N_INPUTS || in_sizes[0] != M * D || out_size != M * D || ws_size < WS_END) { fprintf(stderr, "kernel_launch: unexpected shapes (n_in %d, in0 %d, out %d, ws %zu); nothing launched\n", n_in, n_in > 0 ? in_sizes[0] : -1, out_size, ws_size); grid = -1; return; }
        int dev = 0, cus = 0, per_cu = 0;
        if (hipGetDevice(&dev) != hipSuccess || hipDeviceGetAttribute(&cus, hipDeviceAttributeMultiprocessorCount, dev) != hipSuccess) { grid = -1; return; }
        if (hipFuncSetAttribute((const void*)skel_fwd, hipFuncAttributeMaxDynamicSharedMemorySize, LDS_BYTES) != hipSuccess) { fprintf(stderr, "kernel_launch: hipFuncSetAttribute failed\n"); grid = -1; return; }
        if (hipOccupancyMaxActiveBlocksPerMultiprocessor(&per_cu, (const void*)skel_fwd, NTHR, LDS_BYTES) != hipSuccess || per_cu < 1) fprintf(stderr, "kernel_launch: occupancy query reports %d\n", per_cu);
        (void)hipGetLastError();
        grid = cus;
    }
    if (grid < 0) return;
    (void)hipMemsetAsync((char*)d_ws + WS_CTL, 0, CTL_ZERO_BYTES, stream);
    Args a{};
    for (int i = 0; i < N_INPUTS; ++i) a.in[i] = (const float*)d_in[i];
    a.out = (float*)d_out; a.ws = (unsigned char*)d_ws;
#if MK_ONE_LAUNCH
    a.ph_lo = 0; a.ph_hi = NPH;
    hipLaunchKernelGGL(skel_fwd, dim3(grid), dim3(NTHR), LDS_BYTES, stream, a);
#else
    for (int p = 0; p < NPH; ++p) { a.ph_lo = p; a.ph_hi = p + 1; hipLaunchKernelGGL(skel_fwd, dim3(grid), dim3(NTHR), LDS_BYTES, stream, a); }
#endif
}
```

```cpp
#include <hip/hip_runtime.h>
#include <cstdio>
#include <cstdint>
namespace pg8 {
#define PG8_LAS __attribute__((address_space(3)))
typedef unsigned short bf16_t;
typedef short bf16x8 __attribute__((ext_vector_type(8)));
typedef float f32x4 __attribute__((ext_vector_type(4)));
typedef unsigned u32x4 __attribute__((ext_vector_type(4)));
constexpr int BM = 256, BK = 64, HALF = 128, HTB = HALF * BK * 2  , STAGE_BYTES = 8 * HTB, NXCD = 8, WGM = 8;

__host__ __device__ __forceinline__ int lds_byte(int r, int c) { const int st = (r >> 4) * 2 + (c >> 5), rr = r & 15, cc = c & 31, ob = rr * 64 + cc * 2; return st * 1024 + (ob ^ (((ob >> 9) & 1) << 5)); }
__host__ __device__ __forceinline__ void stage_rc(int b, int& R, int& C) { const int st = b / 1024, sb = b % 1024, swz = sb ^ (((sb >> 9) & 1) << 5); R = (st >> 1) * 16 + swz / 64; C = (st & 1) * 32 + (swz % 64) / 2; }
__host__ __device__ __forceinline__ int perm32(int rho) { const int n = rho >> 4, i = rho & 15; return 8 * (i >> 2) + 4 * n + (i & 3); }

struct Unit { int pm, pn; };
struct Gemm { const bf16_t* A; const bf16_t* Bt; int M, N, K; };

struct StaticOrder {
    int nM, nN, nwg, G, c;
    __host__ __device__ void init(int M, int N, int G_, int c_) { nM = M / BM; nN = N / BM; nwg = nM * nN; G = G_; c = c_; }
    __host__ __device__ bool next(int i, Unit& u) const {
        const long L = (long)i * G + c; if (L >= nwg) return false;
        int wgid = (int)L; { const int q = nwg / NXCD, r = nwg % NXCD, xcd = wgid % NXCD, off = wgid / NXCD; wgid = (xcd < r ? xcd * (q + 1) : r * (q + 1) + (xcd - r) * q) + off; }
        const int nig = WGM * nN, gid = wgid / nig, fm = gid * WGM, gsz = (nM - fm) < WGM ? (nM - fm) : WGM;
        u.pm = fm + ((wgid % nig) % gsz); u.pn = (wgid % nig) / gsz; return true;
    }
    __device__ __forceinline__ void a_ready(const Unit&) const {}
    __device__ __forceinline__ void done(const Unit&) const {}
};

__device__ __forceinline__ unsigned cvt_pk_bf16(float lo, float hi) { unsigned r; asm volatile("v_cvt_pk_bf16_f32 %0, %1, %2" : "=v"(r) : "v"(lo), "v"(hi)); return r; }
typedef float f32x2 __attribute__((ext_vector_type(2)));
typedef unsigned u32x2 __attribute__((ext_vector_type(2)));
__device__ __forceinline__ float bf_lo(unsigned w) { return __uint_as_float(w << 16); }
__device__ __forceinline__ float bf_hi(unsigned w) { return __uint_as_float(w & 0xffff0000u); }
__device__ __forceinline__ float sigmoid_f(float x) { return __builtin_amdgcn_rcpf(1.0f + __builtin_amdgcn_exp2f(-1.4426950408889634f * x)); }
__device__ __forceinline__ float silu_f(float x) { return x * sigmoid_f(x); }
__device__ __forceinline__ u32x4 pack8(const f32x4 v0, const f32x4 v1) { u32x4 w; w.x = cvt_pk_bf16(v0[0], v0[1]); w.y = cvt_pk_bf16(v0[2], v0[3]); w.z = cvt_pk_bf16(v1[0], v1[1]); w.w = cvt_pk_bf16(v1[2], v1[3]); return w; }

struct EpiF32 {
    static constexpr bool PERM = false, AFTER_DRAIN = false;
    float* C; int ldc;
    __device__ __forceinline__ void operator()(const f32x4 (&acc)[2][2][4][2], const Unit& u, int wr, int wc, int fr, int fq) const {
        const int row0 = u.pm * BM + wr * 64 + fr, col0 = u.pn * BM + wc * 32 + 4 * fq;
#pragma unroll
        for (int ai = 0; ai < 2; ++ai)
#pragma unroll
            for (int m = 0; m < 4; ++m) { float* rowp = C + (size_t)(row0 + ai * HALF + m * 16) * ldc + col0;
#pragma unroll
                for (int bj = 0; bj < 2; ++bj)
#pragma unroll
                    for (int n = 0; n < 2; ++n) *(f32x4*)(rowp + bj * HALF + n * 16) = acc[ai][bj][m][n]; }
    }
};
struct EpiSwiGLU {
    static constexpr bool PERM = true, AFTER_DRAIN = false;
    bf16_t* O; int ldc;
    __device__ __forceinline__ void operator()(const f32x4 (&acc)[2][2][4][2], const Unit& u, int wr, int wc, int fr, int fq) const {
        const int row0 = u.pm * BM + wr * 64 + fr, col0 = u.pn * HALF + wc * 32 + 8 * fq;
#pragma unroll
        for (int ai = 0; ai < 2; ++ai)
#pragma unroll
            for (int m = 0; m < 4; ++m) { bf16_t* rowp = O + (size_t)(row0 + ai * HALF + m * 16) * ldc + col0;
                f32x4 v0, v1;
#pragma unroll
                for (int j = 0; j < 4; ++j) { v0[j] = silu_f(acc[ai][0][m][0][j]) * acc[ai][1][m][0][j]; v1[j] = silu_f(acc[ai][0][m][1][j]) * acc[ai][1][m][1][j]; }
                *(u32x4*)rowp = pack8(v0, v1); }
    }
};
template <class Op> struct EpiRow8 {
    static constexpr bool PERM = true, AFTER_DRAIN = false;
    Op op;
    __device__ __forceinline__ void operator()(const f32x4 (&acc)[2][2][4][2], const Unit& u, int wr, int wc, int fr, int fq) const {
        const int row0 = u.pm * BM + wr * 64 + fr, tc0 = wc * 32 + 8 * fq;
#pragma unroll
        for (int ai = 0; ai < 2; ++ai)
#pragma unroll
            for (int m = 0; m < 4; ++m)
#pragma unroll
                for (int bj = 0; bj < 2; ++bj) op.st(row0 + ai * HALF + m * 16, tc0 + bj * HALF, u, acc[ai][bj][m][0], acc[ai][bj][m][1]);
    }
};
struct OpQKV { bf16_t* Q; size_t stride; float qscale;
    __device__ __forceinline__ void st(int row, int tc, const Unit& u, f32x4 v0, f32x4 v1) const {
        const int t = u.pn >> 2, col = (u.pn & 3) * BM + tc; const float sc = (t == 0) ? qscale : 1.0f;
        *(u32x4*)(Q + (size_t)t * stride + (size_t)row * 1024 + col) = pack8(v0 * sc, v1 * sc); } };
struct OpZX { bf16_t* Z; bf16_t* XBC;
    __device__ __forceinline__ void st(int row, int tc, const Unit& u, f32x4 v0, f32x4 v1) const {
        if (u.pn < 8) {
#pragma unroll
            for (int j = 0; j < 4; ++j) { v0[j] = silu_f(v0[j]); v1[j] = silu_f(v1[j]); }
            *(u32x4*)(Z + (size_t)row * 2048 + u.pn * BM + tc) = pack8(v0, v1);
        } else *(u32x4*)(XBC + (size_t)row * 3072 + (u.pn - 8) * BM + tc) = pack8(v0, v1); } };
struct OpGate { bf16_t* G; const float* bias;
    __device__ __forceinline__ void st(int row, int tc, const Unit& u, f32x4 v0, f32x4 v1) const {
        const int col = u.pn * BM + tc; const f32x4 b0 = *(const f32x4*)(bias + col), b1 = *(const f32x4*)(bias + col + 4);
#pragma unroll
        for (int j = 0; j < 4; ++j) { v0[j] = sigmoid_f(v0[j] + b0[j]); v1[j] = sigmoid_f(v1[j] + b1[j]); }
        *(u32x4*)(G + (size_t)row * 2048 + col) = pack8(v0, v1); } };
template <bool FIRST> struct OpMerge { bf16_t* Mg; const bf16_t* G;
    __device__ __forceinline__ void st(int row, int tc, const Unit& u, f32x4 v0, f32x4 v1) const {
        const int col = u.pn * BM + tc; const u32x4 g = *(const u32x4*)(G + (size_t)row * 2048 + (FIRST ? 0 : 1024) + col);
        v0[0] *= bf_lo(g.x); v0[1] *= bf_hi(g.x); v0[2] *= bf_lo(g.y); v0[3] *= bf_hi(g.y); v1[0] *= bf_lo(g.z); v1[1] *= bf_hi(g.z); v1[2] *= bf_lo(g.w); v1[3] *= bf_hi(g.w);
        bf16_t* p = Mg + (size_t)row * 1024 + col;
        if (!FIRST) { const u32x4 o = *(const u32x4*)p;
            v0[0] += bf_lo(o.x); v0[1] += bf_hi(o.x); v0[2] += bf_lo(o.y); v0[3] += bf_hi(o.y); v1[0] += bf_lo(o.z); v1[1] += bf_hi(o.z); v1[2] += bf_lo(o.w); v1[3] += bf_hi(o.w); }
        *(u32x4*)p = pack8(v0, v1); } };
template <class Epi, class Sched, bool ALIGN_EPI = false, bool SP2 = false>
__device__ __forceinline__ void gemm_phase(PG8_LAS unsigned char* lds, const Gemm g, const Sched& S, const Epi& E) {
    const int tid = threadIdx.x, wid = __builtin_amdgcn_readfirstlane(tid >> 6), lane = tid & 63, wr = wid >> 2, wc = wid & 3, fr = lane & 15, fq = lane >> 4;
    const int K = g.K, nt = K / BK;
    unsigned voffA[2], voffB[2];
#pragma unroll
    for (int i = 0; i < 2; ++i) { int R, C; stage_rc(tid * 16 + i * 8192, R, C); const int Rb = Epi::PERM ? ((R & ~31) + perm32(R & 31)) : R;
        voffA[i] = (unsigned)(R * K + C) * 2u; voffB[i] = (unsigned)(Rb * K + C) * 2u; }
    const size_t kstep = (size_t)(BK * 2);
    const size_t hstep = (size_t)HALF * K * 2;
    const size_t tstep = 2 * hstep;
    const unsigned ldsw = (unsigned)wid * 1024u;
    const int aoff = lds_byte(wr * 64 + fr, fq * 8), boff = lds_byte(wc * 32 + fr, fq * 8);
#define PG8_SA(b, h) (((b) * 2 + (h)) * HTB)
#define PG8_SB(b, h) ((4 + (b) * 2 + (h)) * HTB)
#define PG8_STAGE(bufoff, gbase, voff) do { _Pragma("unroll") for (int _i = 0; _i < 2; ++_i) \
        __builtin_amdgcn_global_load_lds((const unsigned*)((const char*)(gbase) + (voff)[_i]), (PG8_LAS unsigned*)(lds + (bufoff) + ldsw + _i * 8192), 16, 0, 0); } while (0)
#define PG8_LDA(dst, b, h) do { _Pragma("unroll") for (int m = 0; m < 4; ++m) _Pragma("unroll") for (int k = 0; k < 2; ++k) dst[m][k] = *(const PG8_LAS bf16x8*)(lds + PG8_SA(b, h) + aoff + m * 2048 + k * 1024); } while (0)
#define PG8_LDB(dst, b, h) do { _Pragma("unroll") for (int n = 0; n < 2; ++n) _Pragma("unroll") for (int k = 0; k < 2; ++k) dst[n][k] = *(const PG8_LAS bf16x8*)(lds + PG8_SB(b, h) + boff + n * 2048 + k * 1024); } while (0)
#define PG8_MMA(ai, bj, At, Bt) do { __builtin_amdgcn_s_setprio(1); _Pragma("unroll") for (int m = 0; m < 4; ++m) _Pragma("unroll") for (int n = 0; n < 2; ++n) _Pragma("unroll") for (int k = 0; k < 2; ++k) \
        acc[ai][bj][m][n] = __builtin_amdgcn_mfma_f32_16x16x32_bf16(Bt[n][k], At[m][k], acc[ai][bj][m][n], 0, 0, 0); __builtin_amdgcn_s_setprio(0); } while (0)
#define PG8_WAIT_V(n) asm volatile("s_waitcnt vmcnt(" #n ")" ::: "memory")
#define PG8_WAIT_L(n) asm volatile("s_waitcnt lgkmcnt(" #n ")" ::: "memory")
#define PG8_BAR __builtin_amdgcn_s_barrier()
#define PG8_SCHED __builtin_amdgcn_sched_barrier(0)
    Unit cur, nxt; int ui = 0;
    if (!S.next(0, cur)) return;
    f32x4 acc[2][2][4][2];
#pragma unroll
    for (int a = 0; a < 2; ++a)
#pragma unroll
        for (int b = 0; b < 2; ++b)
#pragma unroll
            for (int m = 0; m < 4; ++m)
#pragma unroll
                for (int n = 0; n < 2; ++n) acc[a][b][m][n] = (f32x4){0.f, 0.f, 0.f, 0.f};
    bf16x8 At[4][2], B0[2][2], B1[2][2];
    const char* cA = (const char*)g.A + (size_t)cur.pm * tstep; const char* cB = (const char*)g.Bt + (size_t)cur.pn * tstep;
    S.a_ready(cur);
    if constexpr (SP2) {
        PG8_STAGE(PG8_SB(0, 0), cB, voffB); PG8_STAGE(PG8_SB(0, 1), cB + hstep, voffB); PG8_STAGE(PG8_SA(0, 0), cA, voffA); PG8_STAGE(PG8_SA(0, 1), cA + hstep, voffA);
        if (wr == 1) PG8_BAR;
        PG8_WAIT_V(2); PG8_BAR;
        PG8_STAGE(PG8_SB(1, 0), cB + kstep, voffB); PG8_STAGE(PG8_SA(1, 0), cA + kstep, voffA); PG8_STAGE(PG8_SB(1, 1), cB + hstep + kstep, voffB);
        PG8_WAIT_V(6); PG8_BAR;
    } else {
        PG8_STAGE(PG8_SB(0, 0), cB, voffB); PG8_STAGE(PG8_SA(0, 0), cA, voffA); PG8_STAGE(PG8_SB(0, 1), cB + hstep, voffB); PG8_STAGE(PG8_SA(0, 1), cA + hstep, voffA);
        if (wr == 1) PG8_BAR;
        PG8_WAIT_V(4); PG8_BAR;
        PG8_STAGE(PG8_SB(1, 0), cB + kstep, voffB); PG8_STAGE(PG8_SA(1, 0), cA + kstep, voffA); PG8_STAGE(PG8_SB(1, 1), cB + hstep + kstep, voffB);
        PG8_WAIT_V(6); PG8_BAR;
    }
    for (;;) {
        const bool has_next = S.next(ui + 1, nxt);
        const char* nA = has_next ? (const char*)g.A + (size_t)nxt.pm * tstep : cA; const char* nB = has_next ? (const char*)g.Bt + (size_t)nxt.pn * tstep : cB;
        for (int t = 0; t < nt; t += 2) {
            const bool last = (t == nt - 2);
            const char* a1 = cA + (size_t)(t + 1) * kstep;
            const char* a2 = last ? nA : cA + (size_t)(t + 2) * kstep; const char* b2 = last ? nB : cB + (size_t)(t + 2) * kstep;
            const char* a3 = a2 + kstep; const char* b3 = b2 + kstep;
            if (last && has_next) S.a_ready(nxt);
            if constexpr (SP2) {
            PG8_LDB(B0, 0, 0); PG8_LDB(B1, 0, 1); PG8_SCHED; PG8_LDA(At, 0, 0); PG8_STAGE(PG8_SA(1, 1), a1 + hstep, voffA);
            PG8_WAIT_V(8); PG8_WAIT_L(0); PG8_BAR; PG8_MMA(0, 0, At, B0); PG8_MMA(0, 1, At, B1); PG8_BAR; PG8_SCHED;
            PG8_LDA(At, 0, 1); PG8_STAGE(PG8_SB(0, 0), b2, voffB); PG8_STAGE(PG8_SB(0, 1), b2 + hstep, voffB); PG8_STAGE(PG8_SA(0, 0), a2, voffA);
            PG8_WAIT_V(8); PG8_WAIT_L(0); PG8_BAR; PG8_MMA(1, 0, At, B0); PG8_MMA(1, 1, At, B1); PG8_BAR; PG8_SCHED;
            PG8_LDB(B0, 1, 0); PG8_LDB(B1, 1, 1); PG8_SCHED; PG8_LDA(At, 1, 0); PG8_STAGE(PG8_SA(0, 1), a2 + hstep, voffA);
            PG8_WAIT_V(8); PG8_WAIT_L(0); PG8_BAR; PG8_MMA(0, 0, At, B0); PG8_MMA(0, 1, At, B1); PG8_BAR; PG8_SCHED;
            PG8_LDA(At, 1, 1); PG8_STAGE(PG8_SB(1, 0), b3, voffB); PG8_STAGE(PG8_SB(1, 1), b3 + hstep, voffB); PG8_STAGE(PG8_SA(1, 0), a3, voffA);
            PG8_WAIT_V(8); PG8_WAIT_L(0); PG8_BAR; PG8_MMA(1, 0, At, B0); PG8_MMA(1, 1, At, B1); PG8_BAR; PG8_SCHED;
            } else {
            PG8_LDB(B0, 0, 0); PG8_SCHED; PG8_LDA(At, 0, 0); PG8_STAGE(PG8_SA(1, 1), a1 + hstep, voffA);
            PG8_WAIT_L(8); PG8_BAR; PG8_WAIT_L(0); PG8_MMA(0, 0, At, B0); PG8_BAR; PG8_SCHED;
            PG8_LDB(B1, 0, 1); PG8_STAGE(PG8_SB(0, 0), b2, voffB);
            PG8_BAR; PG8_WAIT_L(0); PG8_MMA(0, 1, At, B1); PG8_BAR;
            PG8_LDA(At, 0, 1); PG8_STAGE(PG8_SA(0, 0), a2, voffA);
            PG8_BAR; PG8_WAIT_L(0); PG8_MMA(1, 0, At, B0); PG8_BAR; PG8_SCHED;
            PG8_STAGE(PG8_SB(0, 1), b2 + hstep, voffB);
            PG8_WAIT_V(6); PG8_BAR; PG8_MMA(1, 1, At, B1); PG8_BAR;
            PG8_LDB(B0, 1, 0); PG8_SCHED; PG8_LDA(At, 1, 0); PG8_STAGE(PG8_SA(0, 1), a2 + hstep, voffA);
            PG8_WAIT_L(8); PG8_BAR; PG8_WAIT_L(0); PG8_MMA(0, 0, At, B0); PG8_BAR; PG8_SCHED;
            PG8_LDB(B1, 1, 1); PG8_STAGE(PG8_SB(1, 0), b3, voffB);
            PG8_BAR; PG8_WAIT_L(0); PG8_MMA(0, 1, At, B1); PG8_BAR;
            PG8_LDA(At, 1, 1); PG8_STAGE(PG8_SA(1, 0), a3, voffA);
            PG8_BAR; PG8_WAIT_L(0); PG8_MMA(1, 0, At, B0); PG8_BAR; PG8_SCHED;
            PG8_STAGE(PG8_SB(1, 1), b3 + hstep, voffB);
            PG8_WAIT_V(6); PG8_BAR; PG8_MMA(1, 1, At, B1); PG8_BAR;
            }
        }
        if constexpr (ALIGN_EPI) { if (wr == 0) PG8_BAR; }
        if constexpr (!Epi::AFTER_DRAIN) { E(acc, cur, wr, wc, fr, fq); S.done(cur); }
        if (!has_next) break;
#pragma unroll
        for (int a = 0; a < 2; ++a)
#pragma unroll
            for (int b = 0; b < 2; ++b)
#pragma unroll
                for (int m = 0; m < 4; ++m)
#pragma unroll
                    for (int n = 0; n < 2; ++n) acc[a][b][m][n] = (f32x4){0.f, 0.f, 0.f, 0.f};
        cur = nxt; cA = nA; cB = nB; ++ui;
        if constexpr (ALIGN_EPI) { if (wr == 1) PG8_BAR; }
    }
    PG8_WAIT_V(0);
    if constexpr (!ALIGN_EPI) { if (wr == 0) PG8_BAR; }
    PG8_BAR;
    if constexpr (Epi::AFTER_DRAIN) { E.fused(acc, cur, wr, wc, fr, fq, lds, wid, lane); S.done(cur); }
#undef PG8_SA
#undef PG8_SB
#undef PG8_STAGE
#undef PG8_LDA
#undef PG8_LDB
#undef PG8_MMA
#undef PG8_WAIT_V
#undef PG8_WAIT_L
#undef PG8_BAR
#undef PG8_SCHED
}
}
#include <hip/hip_bf16.h>
#include <cmath>
namespace attn_body {
using bf16=__hip_bfloat16;
using bf16x8=__attribute__((ext_vector_type(8)))short;
using s16x4=__attribute__((ext_vector_type(4)))short;
using f32x16=__attribute__((ext_vector_type(16)))float;
using u32x4=__attribute__((ext_vector_type(4)))unsigned;
constexpr int BATCH=8,NHEAD=16,SEQ=2048,D=64,DM=NHEAD*D,OPITCH=2048;
constexpr int NW=8,QBLK=32,QB=QBLK*NW,KVBLK=64,NQB=SEQ/QB;
constexpr int ATTN_PITCH=DM, ATTN_UNIT_ROWS=QB;
__device__ __forceinline__ int crow(int r,int hi){return (r&3)+8*(r>>2)+4*hi;}
#define SBAR() __builtin_amdgcn_sched_barrier(0)
__device__ __forceinline__ void cmask(f32x16&p0,f32x16&p1,int jb,int qrel,int hi){
  const float NEG=-INFINITY; int kb=64*jb+4*hi;
  #pragma unroll
  for(int r=0;r<16;++r){int kv=kb+(r&3)+8*(r>>2); if(kv>qrel)p0[r]=NEG; if(kv+32>qrel)p1[r]=NEG;}
}

constexpr int NSLOT=3, SLOTB=8192;
constexpr int LDS_K=0, LDS_V=NSLOT*SLOTB, LDS_WS=2*NSLOT*SLOTB, LDS_OST=LDS_WS+NW*64*4, LDS_BYTES=LDS_OST+NW*4096;
constexpr float C2=0.125f*1.4426950408889634f;
__device__ __forceinline__ void glds16(const void*gsrc,unsigned lds_dst){unsigned keep;
  asm volatile("s_mov_b32 %0, m0\n\ts_mov_b32 m0, %2\n\ts_nop 0\n\tglobal_load_lds_dwordx4 %1, off\n\ts_mov_b32 m0, %0":"=&s"(keep):"v"(gsrc),"s"(lds_dst):"memory");}
__device__ __forceinline__ float max3f(float a,float b,float c){float r;asm("v_max3_f32 %0, %1, %2, %3":"=v"(r):"v"(a),"v"(b),"v"(c));return r;}
__device__ __forceinline__ float max2f(float a,float b){float r;asm("v_max_f32_e32 %0, %1, %2":"=v"(r):"v"(a),"v"(b));return r;}
__device__ __forceinline__ float fadd_s(float a,float b){float r;asm("v_add_f32_e32 %0, %1, %2":"=v"(r):"v"(a),"v"(b));return r;}
__device__ __forceinline__ float fsub_s(float a,float b){float r;asm("v_sub_f32_e32 %0, %1, %2":"=v"(r):"v"(a),"v"(b));return r;}
typedef float f32x2_t __attribute__((ext_vector_type(2))); typedef __bf16 bf16x2_t __attribute__((ext_vector_type(2)));
__device__ __forceinline__ unsigned cvtpk_s(float lo,float hi){f32x2_t v={lo,hi};bf16x2_t b=__builtin_convertvector(v,bf16x2_t);return __builtin_bit_cast(unsigned,b);}
#define WAIT_BAR(N) asm volatile("s_waitcnt vmcnt(" #N ") lgkmcnt(0)\n\ts_barrier":::"memory")

__device__ __forceinline__ void qkt(f32x16&p0,f32x16&p1,const char*Kslot,const bf16x8*qr,const f32x16&negm,int r32,int hi,bf16x8 ka0,bf16x8 ka1,bf16x8 qaug){
  const char*kb=Kslot+hi*1024+r32*16;
  #pragma unroll
  for(int d0=0;d0<4;++d0){
    const bf16x8 b0=*reinterpret_cast<const bf16x8*>(kb+d0*2048);
    const bf16x8 b1=*reinterpret_cast<const bf16x8*>(kb+d0*2048+512);
    if(d0==0){p0=__builtin_amdgcn_mfma_f32_32x32x16_bf16(b0,qr[0],negm,0,0,0);p1=__builtin_amdgcn_mfma_f32_32x32x16_bf16(b1,qr[0],negm,0,0,0);}
    else{p0=__builtin_amdgcn_mfma_f32_32x32x16_bf16(b0,qr[d0],p0,0,0,0);p1=__builtin_amdgcn_mfma_f32_32x32x16_bf16(b1,qr[d0],p1,0,0,0);}}
  p0=__builtin_amdgcn_mfma_f32_32x32x16_bf16(ka0,qaug,p0,0,0,0);p1=__builtin_amdgcn_mfma_f32_32x32x16_bf16(ka1,qaug,p1,0,0,0);
}
typedef __attribute__((address_space(3))) const char* lds_cptr;
typedef short v4i16_t __attribute__((ext_vector_type(4)));
__device__ __forceinline__ void kload8(bf16x8*kf,lds_cptr kp){
  kf[0]=*(const __attribute__((address_space(3))) bf16x8*)(kp);      kf[1]=*(const __attribute__((address_space(3))) bf16x8*)(kp+512);
  kf[2]=*(const __attribute__((address_space(3))) bf16x8*)(kp+2048); kf[3]=*(const __attribute__((address_space(3))) bf16x8*)(kp+2560);
  kf[4]=*(const __attribute__((address_space(3))) bf16x8*)(kp+4096); kf[5]=*(const __attribute__((address_space(3))) bf16x8*)(kp+4608);
  kf[6]=*(const __attribute__((address_space(3))) bf16x8*)(kp+6144); kf[7]=*(const __attribute__((address_space(3))) bf16x8*)(kp+6656);
}
__device__ __forceinline__ void kload2(bf16x8*kf,lds_cptr kp,int j){ kf[2*j]=*(const __attribute__((address_space(3))) bf16x8*)(kp+j*2048); kf[2*j+1]=*(const __attribute__((address_space(3))) bf16x8*)(kp+j*2048+512); }
__device__ __forceinline__ s16x4 vtr(lds_cptr p){ return __builtin_bit_cast(s16x4,__builtin_amdgcn_ds_read_tr16_b64_v4i16((__attribute__((address_space(3))) v4i16_t*)p)); }
__device__ __forceinline__ float rowmax(const f32x16&p0,const f32x16&p1){
  float a=max3f(p0[0],p0[1],p1[0]),b=max3f(p0[2],p0[3],p1[1]);a=max3f(a,p1[2],p1[3]);
  #pragma unroll
  for(int r=4;r<16;r+=4){a=max3f(a,p0[r],p0[r+1]);b=max3f(b,p0[r+2],p0[r+3]);a=max3f(a,p1[r],p1[r+1]);b=max3f(b,p1[r+2],p1[r+3]);}
  const float m=max2f(a,b);
  auto rr=__builtin_amdgcn_permlane32_swap(__float_as_uint(m),__float_as_uint(m),false,false);
  return max2f(__uint_as_float(rr[0]),__uint_as_float(rr[1]));
}
__device__ __forceinline__ void pv(f32x16*o,int vb,bf16x8 pa0,bf16x8 pa1,bf16x8 pa2,bf16x8 pa3){
  #pragma unroll
  for(int d0=0;d0<2;++d0){s16x4 lo[4],hi[4];
    #pragma unroll
    for(int ks=0;ks<4;++ks){
      asm volatile("ds_read_b64_tr_b16 %0,%1 offset:%c2":"=&v"(lo[ks]):"v"(vb),"i"(d0*4096+ks*1024):"memory");
      asm volatile("ds_read_b64_tr_b16 %0,%1 offset:%c2":"=&v"(hi[ks]):"v"(vb),"i"(d0*4096+ks*1024+512):"memory");}
    asm volatile("s_waitcnt lgkmcnt(0)":::"memory");SBAR();
    #define PK(k) (bf16x8){lo[k][0],lo[k][1],lo[k][2],lo[k][3],hi[k][0],hi[k][1],hi[k][2],hi[k][3]}
    o[d0]=__builtin_amdgcn_mfma_f32_32x32x16_bf16(pa0,PK(0),o[d0],0,0,0);
    o[d0]=__builtin_amdgcn_mfma_f32_32x32x16_bf16(pa1,PK(1),o[d0],0,0,0);
    o[d0]=__builtin_amdgcn_mfma_f32_32x32x16_bf16(pa2,PK(2),o[d0],0,0,0);
    o[d0]=__builtin_amdgcn_mfma_f32_32x32x16_bf16(pa3,PK(3),o[d0],0,0,0);
    #undef PK
  }
}

#ifndef ATTN_STORE16
#define ATTN_STORE16(p,v) (*(u32x4*)(p)=(v))
#endif
template<int THRL> __device__ __forceinline__ void attn_unit(int b,int hm,int vh,int qb,const bf16*Q,const bf16*__restrict__ K,const bf16*__restrict__ V,bf16*O,char*shm){
  const int tid=threadIdx.x,lane=tid&63,r32=lane&31,hi=lane>>5; const int wid=__builtin_amdgcn_readfirstlane(tid>>6);
  const long rowbase=(long)b*SEQ; const int q0=qb*QB;
  const bf16*Qw=Q+(rowbase+q0+wid*QBLK)*DM+hm*D;
  const bf16*Kh=K+rowbase*DM+hm*D,*Vh=V+rowbase*DM+(hm>>1)*128+vh*D;
  bf16x8 qaug, ka0, ka1; unsigned kaw1;
  { const float sl2=__builtin_amdgcn_exp2f(-(float)((hm>>1)+1))*1.4426950408889634f; const unsigned shb=__float_as_uint(sl2)&0xffff0000u; const float shi=__uint_as_float(shb); const float slo=sl2-shi;
    const unsigned b_shi=shb>>16, b_slo=(__float_as_uint(slo)+0x7fffu+((__float_as_uint(slo)>>16)&1u))>>16, b_shi32=__float_as_uint(shi*32.f)>>16, b_slo32=__float_as_uint(__uint_as_float(b_slo<<16)*32.f)>>16;
    u32x4 qa={hi?0u:(b_shi32|(b_slo32<<16)), hi?0u:(b_shi|(b_slo<<16)), 0u, 0u}; qaug=__builtin_bit_cast(bf16x8,qa);
    const unsigned rb=__float_as_uint((float)r32)>>16; kaw1=hi?0u:(rb|(rb<<16)); }
  #define KAUG(dst,a_) do{ const unsigned ab_=__float_as_uint((float)(a_))>>16; u32x4 kq_={hi?0u:(ab_|(ab_<<16)), kaw1, 0u, 0u}; dst=__builtin_bit_cast(bf16x8,kq_); }while(0)
  const unsigned lds0=(unsigned)(uintptr_t)shm;
  float*wsf=(float*)(shm+LDS_WS)+wid*64;
  const bf16*ksrc=Kh+(long)lane*DM+wid*8;
  const bf16*vsrc=Vh+(long)(16*(wid&3)+(lane>>2))*DM+(wid>>2)*32+(lane&3)*8;
  const unsigned kdst=lds0+LDS_K+wid*1024, vdst=lds0+LDS_V+wid*1024;
  #define DMA_K(t,slot) glds16(ksrc+(long)(t)*KVBLK*DM,(unsigned)__builtin_amdgcn_readfirstlane(kdst+(slot)))
  #define DMA_V(t,slot) glds16(vsrc+(long)(t)*KVBLK*DM,(unsigned)__builtin_amdgcn_readfirstlane(vdst+(slot)))
  const int vb0=(int)(lds0+LDS_V)+((lane>>4)&1)*32+(lane&3)*8+(4*hi+((lane&15)>>2))*64;
  const char*Kbase=shm+LDS_K; bf16x8 kf[8];
  const lds_cptr shm3=(lds_cptr)shm; const lds_cptr kp0=shm3+LDS_K+hi*1024+r32*16; const lds_cptr vp0=shm3+LDS_V+((lane>>4)&1)*32+(lane&3)*8+(4*hi+((lane&15)>>2))*64;
  const int NT=(q0+QB)/KVBLK;
  DMA_K(0,0);DMA_V(0,0);DMA_K(1,SLOTB);
  bf16x8 qr[4];
  #pragma unroll
  for(int d0=0;d0<4;++d0)qr[d0]=*reinterpret_cast<const bf16x8*>(&Qw[(long)r32*DM+d0*16+hi*8]);
  float mhat=0.f,l_reg=0.f;f32x16 o[2];o[0]=f32x16{};o[1]=f32x16{};f32x16 negm=f32x16{};asm volatile("":"+v"(negm));
  const int qrel=wid*QBLK+r32;
  #define CMASK(P0,P1,t) do{int jb_=(t)-(NT-4); if(jb_>=0)cmask(P0,P1,jb_,qrel,hi);}while(0)
  bool resc=false;
  #define START(P0,P1) do{ const float rm=rowmax(P0,P1); resc=false; \
    { const float dl=rm; mhat=fadd_s(mhat,dl); \
      _Pragma("unroll") for(int r=0;r<16;++r){P0[r]=fsub_s(P0[r],dl);P1[r]=fsub_s(P1[r],dl);} \
      _Pragma("unroll") for(int r=0;r<16;++r)negm[r]=-mhat; asm volatile("":"+v"(negm)); } \
    _Pragma("unroll") for(int r=0;r<16;++r)P0[r]=__builtin_amdgcn_exp2f(P0[r]); }while(0)
  #define RESC() do{ if(resc){ asm volatile("s_waitcnt lgkmcnt(0)":::"memory"); \
      _Pragma("unroll") for(int d_=0;d_<2;++d_) _Pragma("unroll") for(int r=0;r<16;++r)o[d_][r]*=wsf[crow(r,hi)]; } }while(0)
  f32x16 pA0,pA1,pB0,pB1;
  int sl_prev=0,sl_cur=0,sl_next=SLOTB;
  #define ROT() do{sl_prev=sl_cur;sl_cur=sl_next;sl_next=(sl_next==(NSLOT-1)*SLOTB)?0:sl_next+SLOTB;}while(0)
  DMA_K(2,2*SLOTB);
  WAIT_BAR(3);
  KAUG(ka0,0); KAUG(ka1,1);
  qkt(pA0,pA1,Kbase,qr,negm,r32,hi,ka0,ka1,qaug);asm volatile("s_nop 15\n\ts_nop 7":"+v"(pA0),"+v"(pA1));CMASK(pA0,pA1,0);
  START(pA0,pA1);
  _Pragma("unroll") for(int r=0;r<16;++r)pA1[r]=__builtin_amdgcn_exp2f(pA1[r]);
  WAIT_BAR(0);
  DMA_K(3,0);DMA_V(1,SLOTB);
  ROT();
  kload8(kf,kp0+sl_cur);
  WAIT_BAR(2);
  s16x4 vlo[8],vhi[8]; u32x4 pw0,pw1,pw2,pw3;
  #define PKW(P,B) cvtpk_s(P[B],P[B+1])
  #define PAF(k) __builtin_bit_cast(bf16x8,pw##k)
  #define VFR(i) (bf16x8){vlo[i][0],vlo[i][1],vlo[i][2],vlo[i][3],vhi[i][0],vhi[i][1],vhi[i][2],vhi[i][3]}
  #define PIN(x) asm volatile("":"+v"(x))
  #define MX3(a,b,c) __builtin_fmaxf(__builtin_fmaxf((a),(b)),(c))
  #define GAPA(MF,A0,A1,A2,A3,W0,W1,PW) do{ MF; sacc+=A0; sacc+=A1; sacc+=A2; sacc+=A3; PIN(sacc); W0; W1; PIN(PW); SBAR(); }while(0)
  #define EX(v) __builtin_amdgcn_exp2f(v)
  #define GAPB(MF,X,B) do{ MF; X[B]=EX(X[B]); X[B+1]=EX(X[B+1]); X[B+2]=EX(X[B+2]); X[B+3]=EX(X[B+3]); PIN(X); SBAR(); }while(0)
  #define VRD(i) do{ vlo[i]=vtr(vp_+(((i)>>2)*4096+((i)&3)*1024)); vhi[i]=vtr(vp_+(((i)>>2)*4096+((i)&3)*1024+512)); }while(0)
  #define KRD(G,j) do{ if(G){ kload2(kf,kp0+sl_next,j); SBAR(); } }while(0)
  #define STEP(C0,C1,P0,P1,t,GK,GV,GL) do{ SBAR(); \
    const lds_cptr vp_=vp0+sl_prev; \
    VRD(0); SBAR(); float sacc=(P0[0]+P0[1]); \
    GAPA(C0=__builtin_amdgcn_mfma_f32_32x32x16_bf16(kf[0],qr[0],negm,0,0,0), P0[2],P0[3],P0[4],P0[5],     pw0[0]=PKW(P0,0), pw0[1]=PKW(P0,2), pw0); \
    VRD(4); SBAR(); GAPA(C1=__builtin_amdgcn_mfma_f32_32x32x16_bf16(kf[1],qr[0],negm,0,0,0), P0[6],P0[7],P0[8],P0[9],     pw0[2]=PKW(P0,4), pw0[3]=PKW(P0,6), pw0); \
    VRD(1); SBAR(); GAPA(C0=__builtin_amdgcn_mfma_f32_32x32x16_bf16(kf[2],qr[1],C0,0,0,0),   P0[10],P0[11],P0[12],P0[13], pw1[0]=PKW(P0,8), pw1[1]=PKW(P0,10), pw1); \
    VRD(5); SBAR(); GAPA(C1=__builtin_amdgcn_mfma_f32_32x32x16_bf16(kf[3],qr[1],C1,0,0,0),   P0[14],P0[15],P1[0],P1[1],   pw1[2]=PKW(P0,12),pw1[3]=PKW(P0,14), pw1); \
    VRD(2); SBAR(); GAPA(C0=__builtin_amdgcn_mfma_f32_32x32x16_bf16(kf[4],qr[2],C0,0,0,0),   P1[2],P1[3],P1[4],P1[5],     pw2[0]=PKW(P1,0), pw2[1]=PKW(P1,2), pw2); \
    VRD(6); SBAR(); GAPA(C1=__builtin_amdgcn_mfma_f32_32x32x16_bf16(kf[5],qr[2],C1,0,0,0),   P1[6],P1[7],P1[8],P1[9],     pw2[2]=PKW(P1,4), pw2[3]=PKW(P1,6), pw2); \
    VRD(3); SBAR(); GAPA(C0=__builtin_amdgcn_mfma_f32_32x32x16_bf16(kf[6],qr[3],C0,0,0,0),   P1[10],P1[11],P1[12],P1[13], pw3[0]=PKW(P1,8), pw3[1]=PKW(P1,10), pw3); \
    VRD(7); SBAR(); GAPA(C1=__builtin_amdgcn_mfma_f32_32x32x16_bf16(kf[7],qr[3],C1,0,0,0),   P1[14],P1[15],0.f,0.f,       pw3[2]=PKW(P1,12),pw3[3]=PKW(P1,14), pw3); \
    KAUG(ka0,2*(t)); KAUG(ka1,2*(t)+1); \
    C0=__builtin_amdgcn_mfma_f32_32x32x16_bf16(ka0,qaug,C0,0,0,0); C1=__builtin_amdgcn_mfma_f32_32x32x16_bf16(ka1,qaug,C1,0,0,0); SBAR(); \
    l_reg+=sacc; \
    if(GK){DMA_K((t)+3,sl_cur);} if(GV){DMA_V((t)+1,sl_next);} \
    CMASK(C0,C1,t); \
    { float a=MX3(C0[0],C0[1],C1[0]),b=MX3(C0[2],C0[3],C1[1]); a=MX3(a,C1[2],C1[3]); \
      _Pragma("unroll") for(int r=4;r<16;r+=4){a=MX3(a,C0[r],C0[r+1]);b=MX3(b,C0[r+2],C0[r+3]);a=MX3(a,C1[r],C1[r+1]);b=MX3(b,C1[r+2],C1[r+3]);} \
      float rm=__builtin_fmaxf(a,b); { auto rr=__builtin_amdgcn_permlane32_swap(__float_as_uint(rm),__float_as_uint(rm),false,false); rm=__builtin_fmaxf(__uint_as_float(rr[0]),__uint_as_float(rr[1])); } \
      resc=false; \
      if(__builtin_expect(__any(rm>(float)THRL),0)){ const float dl=__builtin_fmaxf(rm,0.f); mhat+=dl; \
        _Pragma("unroll") for(int r=0;r<16;++r){C0[r]-=dl;C1[r]-=dl;} \
        _Pragma("unroll") for(int r=0;r<16;++r)negm[r]=-mhat; asm volatile("":"+v"(negm)); \
        const float f=__builtin_amdgcn_exp2f(-dl); l_reg*=f; if(hi==0)wsf[r32]=f; resc=true; } } \
    SBAR(); \
    GAPB(o[0]=__builtin_amdgcn_mfma_f32_32x32x16_bf16(PAF(0),VFR(0),o[0],0,0,0), C0,0); \
    GAPB(o[1]=__builtin_amdgcn_mfma_f32_32x32x16_bf16(PAF(0),VFR(4),o[1],0,0,0), C0,4); \
    KRD(GL,0); GAPB(o[0]=__builtin_amdgcn_mfma_f32_32x32x16_bf16(PAF(1),VFR(1),o[0],0,0,0), C0,8); \
    KRD(GL,1); GAPB(o[1]=__builtin_amdgcn_mfma_f32_32x32x16_bf16(PAF(1),VFR(5),o[1],0,0,0), C0,12); \
    KRD(GL,2); GAPB(o[0]=__builtin_amdgcn_mfma_f32_32x32x16_bf16(PAF(2),VFR(2),o[0],0,0,0), C1,0); \
    KRD(GL,3); GAPB(o[1]=__builtin_amdgcn_mfma_f32_32x32x16_bf16(PAF(2),VFR(6),o[1],0,0,0), C1,4); \
    GAPB(o[0]=__builtin_amdgcn_mfma_f32_32x32x16_bf16(PAF(3),VFR(3),o[0],0,0,0), C1,8); \
    GAPB(o[1]=__builtin_amdgcn_mfma_f32_32x32x16_bf16(PAF(3),VFR(7),o[1],0,0,0), C1,12); \
    }while(0)
  int t=1;
  #undef CMASK
  #define CMASK(P0,P1,t) do{}while(0)
  for(;t+5<NT;t+=2){
    STEP(pB0,pB1,pA0,pA1,t,true,true,true);     WAIT_BAR(2); RESC(); ROT();
    STEP(pA0,pA1,pB0,pB1,t+1,true,true,true);   WAIT_BAR(2); RESC(); ROT();
  }
  #undef CMASK
  #define CMASK(P0,P1,t) do{int jb_=(t)-(NT-4); if(jb_>=0)cmask(P0,P1,jb_,qrel,hi);}while(0)
  #define ENDW(tt) do{ if((tt)+3<NT){WAIT_BAR(2);} else if((tt)+2<NT){WAIT_BAR(1);} else {WAIT_BAR(0);} }while(0)
  for(;t+1<NT;t+=2){
    STEP(pB0,pB1,pA0,pA1,t,(t+3<NT),(t+1<NT),(t+1<NT));       ENDW(t);   RESC(); ROT();
    STEP(pA0,pA1,pB0,pB1,t+1,(t+4<NT),(t+2<NT),(t+2<NT));     ENDW(t+1); RESC(); ROT();
  }
  STEP(pB0,pB1,pA0,pA1,NT-1,false,false,false); RESC();
  { float sacc=pB0[0]+pB0[1]; _Pragma("unroll") for(int r=2;r<16;++r)sacc+=pB0[r]; _Pragma("unroll") for(int r=0;r<16;++r)sacc+=pB1[r]; l_reg+=sacc;
    pw0=(u32x4){PKW(pB0,0),PKW(pB0,2),PKW(pB0,4),PKW(pB0,6)};pw1=(u32x4){PKW(pB0,8),PKW(pB0,10),PKW(pB0,12),PKW(pB0,14)};pw2=(u32x4){PKW(pB1,0),PKW(pB1,2),PKW(pB1,4),PKW(pB1,6)};pw3=(u32x4){PKW(pB1,8),PKW(pB1,10),PKW(pB1,12),PKW(pB1,14)};
    SBAR(); pv(o,vb0+sl_cur,PAF(0),PAF(1),PAF(2),PAF(3)); }
  #undef PKW
  #undef PAF
  #undef VFR
  #undef PIN
  #undef MX3
  #undef GAPA
  #undef GAPB
  #undef EX
  #undef VRD
  #undef KRD
  #undef STEP
  #undef ENDW
  {auto rr=__builtin_amdgcn_permlane32_swap(__float_as_uint(l_reg),__float_as_uint(l_reg),false,false);l_reg=__uint_as_float(rr[0])+__uint_as_float(rr[1]);}
  if(hi==0)wsf[32+r32]=l_reg;asm volatile("s_waitcnt lgkmcnt(0)":::"memory");
  float rli[16];
  #pragma unroll
  for(int r=0;r<16;++r)rli[r]=__builtin_amdgcn_rcpf(wsf[32+crow(r,hi)]);
  bf16*Ow=O+(rowbase+q0+wid*QBLK)*OPITCH+hm*128+vh*D;
  { bf16*stg=(bf16*)(shm+LDS_OST)+wid*2048;
    #pragma unroll
    for(int r=0;r<16;++r){const int orow=crow(r,hi);
      #pragma unroll
      for(int d0=0;d0<2;++d0)stg[orow*64+d0*32+r32]=__float2bfloat16(o[d0][r]*rli[r]);}
    asm volatile("s_waitcnt lgkmcnt(0)":::"memory");
    #pragma unroll
    for(int i=0;i<4;++i){const int row=i*8+(lane>>3),ch=lane&7; const u32x4 v=*(const u32x4*)(stg+row*64+ch*8); ATTN_STORE16(Ow+(long)row*OPITCH+ch*8,v);} }
  asm volatile("s_waitcnt lgkmcnt(0)\n\ts_barrier":::"memory");
  #undef DMA_K
  #undef DMA_V
  #undef KAUG
  #undef CMASK
  #undef START
  #undef RESC
  #undef ROT
}
constexpr int ATTN_LDS_BYTES=LDS_BYTES;
struct AttnTensors { const bf16* Q; const bf16* K; const bf16* V; bf16* O; };
struct AttnUnit { int item; int qb; };
struct StaticOrder {
  int vcu, G;
  __device__ __forceinline__ explicit StaticOrder(int grid,int block):vcu((grid%8==0)?(block%8)*(grid/8)+block/8:block),G(grid){}
  __device__ __forceinline__ bool next(int i,AttnUnit&u)const{ const int L=vcu+(i>>3)*G; if(L>=BATCH*NHEAD*2)return false; u.item=L; u.qb=7-(i&7); return true; }
  __device__ __forceinline__ void a_ready(const AttnUnit&)const{}
  __device__ __forceinline__ void done(const AttnUnit&)const{}
};
template<class Sched,int THRL=8> __device__ __forceinline__ void attn_phase(char*lds,const AttnTensors&T,const Sched&S){
  AttnUnit u;
  for(int i=0;S.next(i,u);++i){ S.a_ready(u); attn_unit<THRL>(u.item>>5,(u.item>>1)&15,u.item&1,u.qb,T.Q,T.K,T.V,T.O,lds); S.done(u); }
}
#undef SBAR
#undef WAIT_BAR
}
#define GAS __attribute__((address_space(1)))
#define LAS __attribute__((address_space(3)))
typedef unsigned short bf16;
typedef unsigned v4u __attribute__((ext_vector_type(4)));
typedef float f32x4 __attribute__((ext_vector_type(4)));
typedef short bf16x8 __attribute__((ext_vector_type(8)));
typedef GAS unsigned gu32;
typedef GAS unsigned long long gu64;
#define RLX_AGENT __ATOMIC_RELAXED, __HIP_MEMORY_SCOPE_AGENT
#define LDS_WAIT() asm volatile("s_waitcnt lgkmcnt(0)" ::: "memory")
#define VM_WAIT() asm volatile("s_waitcnt vmcnt(0)" ::: "memory")
__device__ __forceinline__ unsigned long long rt() { return __builtin_amdgcn_s_memrealtime(); }
__device__ __forceinline__ unsigned f2bf(float f) { unsigned u = __builtin_bit_cast(unsigned, f); return (u + 0x7fffu + ((u >> 16) & 1u)) >> 16; }
__device__ __forceinline__ unsigned pk2(float lo, float hi) { return f2bf(lo) | (f2bf(hi) << 16); }

#define XB_TMO      128
#define XB_XCNT(j)  (256  + 64 * (j))
#define XB_XSUB(j)  (1280 + 64 * (j))
#define XB_XGEN(j)  (2304 + 64 * (j))
#define XB_TOP      3328
#define XB_TOPGEN   3392
#define XCD_BAR_WORDS 3456
#define XB_SPIN_CAP (1u << 18)

__device__ __forceinline__ unsigned xb_ld(unsigned* p)              { return __hip_atomic_load(p, __ATOMIC_RELAXED, __HIP_MEMORY_SCOPE_AGENT); }
__device__ __forceinline__ unsigned xb_add(unsigned* p, unsigned v) { return __hip_atomic_fetch_add(p, v, __ATOMIC_RELAXED, __HIP_MEMORY_SCOPE_AGENT); }
__device__ __forceinline__ unsigned xb_xcc_id() { return (unsigned)__builtin_amdgcn_s_getreg((3 << 11) | 20) & 0xFu; }
#define XB_SPIN(cond, bar) do { unsigned _sp = 0; while (cond) { __builtin_amdgcn_s_sleep(1); \
    if ((++_sp & 255u) == 0u) { if (xb_ld(&(bar)[XB_TMO])) break; if (_sp > XB_SPIN_CAP) { atomicAdd(&(bar)[XB_TMO], 1u); break; } } } } while (0)

struct XcdBarrier {
    unsigned* bar; unsigned x;
    volatile LAS unsigned* st;
};

__device__ __forceinline__ XcdBarrier xcd_barrier_post(unsigned* bar, volatile LAS unsigned* st) {
    XcdBarrier b; b.bar = bar; b.x = xb_xcc_id(); b.st = st;
    if (threadIdx.x == 0) (void)xb_add(&bar[XB_XCNT(b.x)], 1u);
    return b;
}
__device__ __forceinline__ void xcd_barrier_complete(unsigned* bar, unsigned x, unsigned& nloc, unsigned& nx) {
    const unsigned G = gridDim.x * gridDim.y * gridDim.z;
    unsigned sum, cnt, mine, sp = 0u;
    for (;;) {
        sum = 0u; cnt = 0u; mine = 0u;
#pragma unroll
        for (unsigned j = 0; j < 16; ++j) { const unsigned c = xb_ld(&bar[XB_XCNT(j)]); sum += c; cnt += (c > 0u) ? 1u : 0u; mine = (j == x) ? c : mine; }
        if (sum == G) break;
        __builtin_amdgcn_s_sleep(1);
        if ((++sp & 255u) == 0u) { if (xb_ld(&bar[XB_TMO])) break; if (sp > XB_SPIN_CAP) { atomicAdd(&bar[XB_TMO], 1u); break; } }
    }
    nloc = mine > 0u ? mine : 1u; nx = cnt > 0u ? cnt : 1u;
}

__device__ __forceinline__ void xcd_barrier(const XcdBarrier& b) {
    asm volatile("s_waitcnt vmcnt(0)" ::: "memory");
    __syncthreads();
    if (threadIdx.x == 0) {
        unsigned* bar = b.bar;
        __builtin_amdgcn_s_waitcnt(0);
        unsigned nloc = b.st[0], nx = b.st[1];
        if (nloc == 0u) { xcd_barrier_complete(bar, b.x, nloc, nx); b.st[0] = nloc; b.st[1] = nx; }
        const unsigned old = xb_add(&bar[XB_XSUB(b.x)], 1u);
        const unsigned gen = old / nloc;
        if (old + 1u == (gen + 1u) * nloc) {
            __builtin_amdgcn_fence(__ATOMIC_RELEASE, "agent");
            asm volatile("s_waitcnt vmcnt(0)" ::: "memory");
            const unsigned og = xb_add(&bar[XB_TOP], 1u);
            const unsigned tg = og / nx;
            if (og + 1u == (tg + 1u) * nx) xb_add(&bar[XB_TOPGEN], 1u);
            else XB_SPIN(xb_ld(&bar[XB_TOPGEN]) == tg, bar);
            __builtin_amdgcn_fence(__ATOMIC_ACQUIRE, "agent");
            xb_add(&bar[XB_XGEN(b.x)], 1u);
            asm volatile("s_waitcnt vmcnt(0)" ::: "memory");
        } else {
            XB_SPIN(xb_ld(&bar[XB_XGEN(b.x)]) == gen, bar);
            __builtin_amdgcn_fence(__ATOMIC_ACQUIRE, "agent");
            asm volatile("s_waitcnt vmcnt(0)" ::: "memory");
        }
    }
    __syncthreads();
}

constexpr int NWAVES = 8, NTHR = NWAVES * 64;
constexpr int BATCH = 8, SEQ = 2048, D = 1024, M = BATCH * SEQ, FF = 2816, NIN = 10272;
constexpr int SSD_INNER = 2048, SSD_H = 32, SSD_P = 64, SSD_N = 128, CONV_CH = 3072;
constexpr int DA_H = 8;
constexpr float EPS = 1e-6f, LOG2E = 1.4426950408889634f;
constexpr float QSCALE = 0.125f * LOG2E;
constexpr float LAM_INIT = 0.2f;
constexpr int NPH = 18;
enum { I_X = 0, I_F1_PRE, I_F1_WG, I_F1_WU, I_F1_WD, I_F1_POST, I_MIX_PRE, I_WIN, I_GATE_B, I_CONV_W, I_CONV_B, I_DT_BIAS, I_A_LOG, I_SSD_D, I_SSD_NORM, I_SSD_W,
       I_LQ1, I_LK1, I_LQ2, I_LK2, I_SUBLN, I_DA_W, I_WOUT, I_MIX_POST, I_F2_PRE, I_F2_WG, I_F2_WU, I_F2_WD, I_F2_POST, N_INPUTS };

constexpr size_t MiB = 1u << 20;
constexpr size_t WS_CTL = 0, CTL_ZERO_BYTES = 1 * MiB;
constexpr size_t WS_WGU = 1 * MiB, WS_WD = 12 * MiB, WS_WQKV = 18 * MiB, WS_WZX = 24 * MiB, WS_WGATE = 34 * MiB, WS_WSSD = 38 * MiB, WS_WDA = 42 * MiB, WS_WOUT = 44 * MiB, WS_WDT = 46 * MiB;
constexpr size_t WS_F1N = 48 * MiB, WS_XN = 80 * MiB;
constexpr size_t WS_H = 112 * MiB;
constexpr size_t WS_Q = 112 * MiB, WS_K = 144 * MiB, WS_V = 176 * MiB;
constexpr size_t WS_AN = 112 * MiB;
constexpr size_t WS_XBC = 144 * MiB;
constexpr size_t WS_DT = 240 * MiB, WS_SSQP = 242 * MiB;
constexpr size_t WS_GATES = 144 * MiB, WS_MERGED = 208 * MiB;
constexpr size_t WS_TMP = 48 * MiB;
constexpr size_t WS_END = 256 * MiB;
constexpr int CW_TMO = 0, CW_CODE = 1, CW_BAR = 4096;

constexpr int RING_OFF = 0, RING_BYTES = 131072;
constexpr int LDSCTL_OFF = RING_BYTES, MISC_OFF = LDSCTL_OFF + 320;
constexpr int LDS_BYTES = 147456;

struct Args { const float* in[N_INPUTS]; float* out; unsigned char* ws; int ph_lo, ph_hi; int pad0, pad1; };
static_assert(sizeof(Args) == N_INPUTS * 8 + 8 + 8 + 16, "Args has no padding holes");

struct Ctx { LAS unsigned char* lds; int tid, lane, wave, vcu, G; };

__device__ __forceinline__ float wave_sum(float v) {
#pragma unroll
    for (int o = 1; o < 64; o <<= 1) v += __shfl_xor(v, o);
    return v;
}
__device__ __forceinline__ float bflo(unsigned w) { return __uint_as_float(w << 16); }
__device__ __forceinline__ float bfhi(unsigned w) { return __uint_as_float(w & 0xffff0000u); }
__device__ __forceinline__ float bf1(bf16 h) { return __uint_as_float((unsigned)h << 16); }
__device__ __forceinline__ float sigm(float x) { return 1.0f / (1.0f + __expf(-x)); }

__device__ __forceinline__ void transpose_item(const float* W, int ldw, int K, bf16* WT, int dst_row0, int k0, int n0, LAS float* scr, int lane) {
#pragma unroll 8
    for (int i = 0; i < 32; ++i) { const int kk = 2 * i + (lane >> 5); scr[kk * 33 + (lane & 31)] = W[(size_t)(k0 + kk) * ldw + n0 + (lane & 31)]; }
    LDS_WAIT(); asm volatile("" ::: "memory");
    const int c = lane & 7;
#pragma unroll
    for (int j = 0; j < 4; ++j) { const int n = (lane >> 3) + 8 * j; const LAS float* s = scr + (8 * c) * 33 + n;
        v4u o; o.x = pk2(s[0 * 33], s[1 * 33]); o.y = pk2(s[2 * 33], s[3 * 33]); o.z = pk2(s[4 * 33], s[5 * 33]); o.w = pk2(s[6 * 33], s[7 * 33]);
        *(GAS v4u*)(WT + (size_t)(dst_row0 + n) * K + k0 + 8 * c) = o; }
    LDS_WAIT(); asm volatile("" ::: "memory");
}
constexpr int FFN_ITEMS = 3 * 16 * 88;
__device__ __forceinline__ void ffn_weight_item(const float* wg, const float* wu, const float* wd, unsigned char* ws, int it, LAS float* scr, int lane) {
    bf16* WGU = (bf16*)(ws + WS_WGU); bf16* WD = (bf16*)(ws + WS_WD);
    if (it < 2 * 1408) { const bool up = it >= 1408; const int r = up ? it - 1408 : it; const int kb = r / 88, nb = r % 88, n0 = nb * 32;
        transpose_item(up ? wu : wg, FF, D, WGU, 256 * (n0 >> 7) + (up ? 128 : 0) + (n0 & 127), kb * 64, n0, scr, lane); }
    else { const int r = it - 2 * 1408; const int kb = r / 32, nb = r % 32;
        transpose_item(wd, D, FF, WD, nb * 32, kb * 64, nb * 32, scr, lane); }
}
constexpr int WIN_ITEMS = 16 * 321, WSSD_ITEMS = 32 * 32, WSQ_ITEMS = 16 * 32;
__device__ __forceinline__ void mixer_weight_item(const Args& a, int it, LAS float* scr, int lane) {
    unsigned char* ws = a.ws;
    if (it < WIN_ITEMS) { const int kb = it / 321, nb = it % 321, n0 = nb * 32; bf16* dst; int row;
        if (n0 < 5120) { dst = (bf16*)(ws + WS_WZX); row = n0; }
        else if (n0 < 5152) { dst = (bf16*)(ws + WS_WDT); row = n0 - 5120; }
        else if (n0 < 8224) { dst = (bf16*)(ws + WS_WQKV); row = n0 - 5152; }
        else { dst = (bf16*)(ws + WS_WGATE); row = n0 - 8224; }
        transpose_item(a.in[I_WIN], NIN, D, dst, row, kb * 64, n0, scr, lane); return; }
    it -= WIN_ITEMS;
    if (it < WSSD_ITEMS) { const int kb = it / 32, nb = it % 32; transpose_item(a.in[I_SSD_W], D, SSD_INNER, (bf16*)(ws + WS_WSSD), nb * 32, kb * 64, nb * 32, scr, lane); return; }
    it -= WSSD_ITEMS;
    if (it < WSQ_ITEMS) { const int kb = it / 32, nb = it % 32; transpose_item(a.in[I_DA_W], D, D, (bf16*)(ws + WS_WDA), nb * 32, kb * 64, nb * 32, scr, lane); return; }
    it -= WSQ_ITEMS;
    { const int kb = it / 32, nb = it % 32; transpose_item(a.in[I_WOUT], D, D, (bf16*)(ws + WS_WOUT), nb * 32, kb * 64, nb * 32, scr, lane); }
}
constexpr int MIXER_ITEMS = WIN_ITEMS + WSSD_ITEMS + 2 * WSQ_ITEMS;

__device__ __forceinline__ void row_load(const float* row, int lane, f32x4 (&v)[4]) {
    const GAS f32x4* p = (const GAS f32x4*)row + lane;
#pragma unroll
    for (int j = 0; j < 4; ++j) v[j] = p[64 * j];
}
__device__ __forceinline__ void row_store(float* row, int lane, const f32x4 (&v)[4]) {
    GAS f32x4* p = (GAS f32x4*)row + lane;
#pragma unroll
    for (int j = 0; j < 4; ++j) p[64 * j] = v[j];
}
__device__ __forceinline__ void row_load_bf(const bf16* row, int lane, f32x4 (&v)[4]) {
    const GAS unsigned long long* p = (const GAS unsigned long long*)row + lane;
#pragma unroll
    for (int j = 0; j < 4; ++j) { const unsigned long long w = p[64 * j]; const unsigned lo = (unsigned)w, hi = (unsigned)(w >> 32); v[j] = (f32x4){bflo(lo), bfhi(lo), bflo(hi), bfhi(hi)}; }
}
__device__ __forceinline__ void row_store_bf_round(bf16* row, int lane, f32x4 (&v)[4]) {
    GAS unsigned long long* p = (GAS unsigned long long*)row + lane;
#pragma unroll
    for (int j = 0; j < 4; ++j) { const unsigned lo = pk2(v[j].x, v[j].y), hi = pk2(v[j].z, v[j].w); p[64 * j] = (unsigned long long)lo | ((unsigned long long)hi << 32);
        v[j] = (f32x4){bflo(lo), bfhi(lo), bflo(hi), bfhi(hi)}; }
}
__device__ __forceinline__ float row_rstd(const f32x4 (&v)[4]) {
    float s = 0.f;
#pragma unroll
    for (int j = 0; j < 4; ++j) s += (v[j].x * v[j].x + v[j].y * v[j].y) + (v[j].z * v[j].z + v[j].w * v[j].w);
    return 1.0f / sqrtf(wave_sum(s) * (1.0f / D) + EPS);
}
__device__ __forceinline__ void row_scale_gain(f32x4 (&v)[4], float s, const float* g, int lane) {
    const GAS f32x4* p = (const GAS f32x4*)g + lane;
#pragma unroll
    for (int j = 0; j < 4; ++j) v[j] = v[j] * s * p[64 * j];
}

__device__ __forceinline__ void ph_prologue(const Args& a, const Ctx& c) {
    LAS float* scr = (LAS float*)(c.lds + RING_OFF + c.wave * 16384);
    const int gw = c.vcu * NWAVES + c.wave, NGW = c.G * NWAVES;
    for (int it = gw; it < FFN_ITEMS + MIXER_ITEMS; it += NGW) {
        if (it < FFN_ITEMS) ffn_weight_item(a.in[I_F1_WG], a.in[I_F1_WU], a.in[I_F1_WD], a.ws, it, scr, c.lane);
        else mixer_weight_item(a, it - FFN_ITEMS, scr, c.lane);
    }
    bf16* XN = (bf16*)(a.ws + WS_XN);
    for (int m = gw; m < M; m += NGW) { f32x4 v[4]; row_load(a.in[I_X] + (size_t)m * D, c.lane, v); const float r = row_rstd(v); row_scale_gain(v, r, a.in[I_F1_PRE], c.lane); row_store_bf_round(XN + (size_t)m * D, c.lane, v); }
}
__device__ __forceinline__ void ph_e2(const Args& a, const Ctx& c) {
    const int gw = c.vcu * NWAVES + c.wave, NGW = c.G * NWAVES; bf16* XN = (bf16*)(a.ws + WS_XN); bf16* F1N = (bf16*)(a.ws + WS_F1N);
    for (int m = gw; m < M; m += NGW) { f32x4 v[4], x[4]; row_load(a.out + (size_t)m * D, c.lane, v); row_load(a.in[I_X] + (size_t)m * D, c.lane, x);
        const float r = row_rstd(v); row_scale_gain(v, 0.5f * r, a.in[I_F1_POST], c.lane); row_store_bf_round(F1N + (size_t)m * D, c.lane, v);
#pragma unroll
        for (int j = 0; j < 4; ++j) v[j] = v[j] + x[j];
        const float r2 = row_rstd(v); row_scale_gain(v, r2, a.in[I_MIX_PRE], c.lane); row_store_bf_round(XN + (size_t)m * D, c.lane, v); }
}
__device__ __forceinline__ void ph_e8(const Args& a, const Ctx& c) {
    const int gw = c.vcu * NWAVES + c.wave, NGW = c.G * NWAVES; bf16* XN = (bf16*)(a.ws + WS_XN); const bf16* F1N = (const bf16*)(a.ws + WS_F1N);
    for (int m = gw; m < M; m += NGW) { f32x4 v[4], x[4], f[4]; row_load(a.out + (size_t)m * D, c.lane, v); row_load(a.in[I_X] + (size_t)m * D, c.lane, x); row_load_bf(F1N + (size_t)m * D, c.lane, f);
        const float r = row_rstd(v); row_scale_gain(v, r, a.in[I_MIX_POST], c.lane);
#pragma unroll
        for (int j = 0; j < 4; ++j) v[j] = v[j] + x[j] + f[j];
        row_store(a.out + (size_t)m * D, c.lane, v);
        const float r2 = row_rstd(v); row_scale_gain(v, r2, a.in[I_F2_PRE], c.lane); row_store_bf_round(XN + (size_t)m * D, c.lane, v); }
}
__device__ __forceinline__ void ph_e10(const Args& a, const Ctx& c) {
    const int gw = c.vcu * NWAVES + c.wave, NGW = c.G * NWAVES; const float* TMP = (const float*)(a.ws + WS_TMP);
    for (int m = gw; m < M; m += NGW) { f32x4 v[4], h[4]; row_load(TMP + (size_t)m * D, c.lane, v); row_load(a.out + (size_t)m * D, c.lane, h);
        const float r = row_rstd(v); row_scale_gain(v, 0.5f * r, a.in[I_F2_POST], c.lane);
#pragma unroll
        for (int j = 0; j < 4; ++j) v[j] = v[j] + h[j];
        row_store(a.out + (size_t)m * D, c.lane, v); }
}
__device__ __forceinline__ void ph_attn_simple(const Args& a, const Ctx& c) {
    const bf16* Q = (const bf16*)(a.ws + WS_Q); const bf16* K = (const bf16*)(a.ws + WS_K); const bf16* V = (const bf16*)(a.ws + WS_V); bf16* O = (bf16*)a.out;
    for (int item = c.vcu; item < BATCH * 32; item += c.G) {
        const int b = item >> 5, hm = (item >> 1) & 15, vh = item & 1, h = hm >> 1;
        const float sl2 = exp2f(-(float)(h + 1)) * LOG2E;
        for (int r = 0; r < 4; ++r) {
            const int qpos = c.tid + NTHR * r; const size_t qrow = (size_t)(b * SEQ + qpos);
            float q[64], o[64];
            { const GAS v4u* qp = (const GAS v4u*)(Q + qrow * 1024 + hm * 64);
#pragma unroll
              for (int i = 0; i < 8; ++i) { const v4u w = qp[i]; q[8 * i] = bflo(w.x); q[8 * i + 1] = bfhi(w.x); q[8 * i + 2] = bflo(w.y); q[8 * i + 3] = bfhi(w.y); q[8 * i + 4] = bflo(w.z); q[8 * i + 5] = bfhi(w.z); q[8 * i + 6] = bflo(w.w); q[8 * i + 7] = bfhi(w.w); } }
#pragma unroll
            for (int d = 0; d < 64; ++d) o[d] = 0.f;
            float mrun = -1e30f, l = 0.f;
            const int jmax = qpos | 63;
            for (int j = 0; j <= jmax; ++j) {
                const GAS v4u* kp = (const GAS v4u*)(K + (size_t)(b * SEQ + j) * 1024 + hm * 64);
                const GAS v4u* vp = (const GAS v4u*)(V + (size_t)(b * SEQ + j) * 1024 + h * 128 + vh * 64);
                float s = 0.f;
#pragma unroll
                for (int i = 0; i < 8; ++i) { const v4u w = kp[i]; s += q[8 * i] * bflo(w.x) + q[8 * i + 1] * bfhi(w.x) + q[8 * i + 2] * bflo(w.y) + q[8 * i + 3] * bfhi(w.y) + q[8 * i + 4] * bflo(w.z) + q[8 * i + 5] * bfhi(w.z) + q[8 * i + 6] * bflo(w.w) + q[8 * i + 7] * bfhi(w.w); }
                s += sl2 * (float)(j - qpos);
                if (j <= qpos) {
                    const float mn = fmaxf(mrun, s), al = exp2f(mrun - mn), p = exp2f(s - mn); l = l * al + p; mrun = mn;
#pragma unroll
                    for (int i = 0; i < 8; ++i) { const v4u w = vp[i];
                        o[8 * i] = o[8 * i] * al + p * bflo(w.x); o[8 * i + 1] = o[8 * i + 1] * al + p * bfhi(w.x); o[8 * i + 2] = o[8 * i + 2] * al + p * bflo(w.y); o[8 * i + 3] = o[8 * i + 3] * al + p * bfhi(w.y);
                        o[8 * i + 4] = o[8 * i + 4] * al + p * bflo(w.z); o[8 * i + 5] = o[8 * i + 5] * al + p * bfhi(w.z); o[8 * i + 6] = o[8 * i + 6] * al + p * bflo(w.w); o[8 * i + 7] = o[8 * i + 7] * al + p * bfhi(w.w); }
                }
            }
            const float rl = 1.0f / l; GAS v4u* op = (GAS v4u*)(O + qrow * 2048 + hm * 128 + vh * 64);
#pragma unroll
            for (int i = 0; i < 8; ++i) { v4u w; w.x = pk2(o[8 * i] * rl, o[8 * i + 1] * rl); w.y = pk2(o[8 * i + 2] * rl, o[8 * i + 3] * rl); w.z = pk2(o[8 * i + 4] * rl, o[8 * i + 5] * rl); w.w = pk2(o[8 * i + 6] * rl, o[8 * i + 7] * rl); op[i] = w; }
        }
    }
}
__device__ __forceinline__ void ph_attn_final(const Args& a, const Ctx& c) {
    const int gw = c.vcu * NWAVES + c.wave, NGW = c.G * NWAVES;
    { LAS float* scr = (LAS float*)(c.lds + RING_OFF + c.wave * 16384);
      for (int it = gw; it < FFN_ITEMS; it += NGW) ffn_weight_item(a.in[I_F2_WG], a.in[I_F2_WU], a.in[I_F2_WD], a.ws, it, scr, c.lane); }
    const float s1 = wave_sum(a.in[I_LQ1][c.lane] * a.in[I_LK1][c.lane]), s2 = wave_sum(a.in[I_LQ2][c.lane] * a.in[I_LK2][c.lane]);
    const float lam = __expf(s1) - __expf(s2) + LAM_INIT;
    const float g0 = a.in[I_SUBLN][2 * c.lane] * (1.0f - LAM_INIT), g1 = a.in[I_SUBLN][2 * c.lane + 1] * (1.0f - LAM_INIT);
    const bf16* O = (const bf16*)a.out; bf16* AN = (bf16*)(a.ws + WS_AN);
    for (int m = gw; m < M; m += NGW) {
        const GAS unsigned* op = (const GAS unsigned*)(O + (size_t)m * 2048) + c.lane; GAS unsigned* ap = (GAS unsigned*)(AN + (size_t)m * 1024) + c.lane;
#pragma unroll
        for (int h = 0; h < DA_H; ++h) { const unsigned w0 = op[h * 128], w1 = op[h * 128 + 64];
            const float x0 = bflo(w0) - lam * bflo(w1), x1 = bfhi(w0) - lam * bfhi(w1);
            const float r = 1.0f / sqrtf(wave_sum(x0 * x0 + x1 * x1) * (1.0f / 128.0f) + EPS);
            ap[h * 64] = pk2(x0 * r * g0, x1 * r * g1); }
    }
}
__device__ __forceinline__ void ph_dt(const Args& a, const Ctx& c) {
    const bf16* XN = (const bf16*)(a.ws + WS_XN); const bf16* WDT = (const bf16*)(a.ws + WS_WDT); float* DT = (float*)(a.ws + WS_DT);
    for (int idx = c.vcu * NTHR + c.tid; idx < M * SSD_H; idx += c.G * NTHR) {
        const int t = idx >> 5, h = idx & 31; const GAS v4u* xp = (const GAS v4u*)(XN + (size_t)t * D); const GAS v4u* wp = (const GAS v4u*)(WDT + (size_t)h * D);
        float s = 0.f;
        for (int i = 0; i < D / 8; ++i) { const v4u x = xp[i], w = wp[i];
            s += bflo(x.x) * bflo(w.x) + bfhi(x.x) * bfhi(w.x) + bflo(x.y) * bflo(w.y) + bfhi(x.y) * bfhi(w.y) + bflo(x.z) * bflo(w.z) + bfhi(x.z) * bfhi(w.z) + bflo(x.w) * bflo(w.w) + bfhi(x.w) * bfhi(w.w); }
        s += a.in[I_DT_BIAS][h];
        DT[idx] = s > 20.f ? s : log1pf(__expf(s));
    }
}
__device__ __forceinline__ void ph_ssd_simple(const Args& a, const Ctx& c) {
    bf16* Z = (bf16*)a.out; const bf16* XBC = (const bf16*)(a.ws + WS_XBC); const float* DT = (const float*)(a.ws + WS_DT); float* SSQP = (float*)(a.ws + WS_SSQP);
    LAS float* xL = (LAS float*)(c.lds); LAS float* BL = xL + 64 * 64; LAS float* CL = BL + 64 * 128; LAS float* yL = CL + 64 * 128; LAS float* dtL = yL + 64 * 64;
    const float* cw = a.in[I_CONV_W]; const float* cb = a.in[I_CONV_B];
    for (int item = c.vcu; item < BATCH * SSD_H; item += c.G) {
        const int b = item >> 5, h = item & 31, g = h >> 3;
        const float Ah = -__expf(a.in[I_A_LOG][h]), Dh = a.in[I_SSD_D][h];
        const int p = c.tid >> 3, nq = c.tid & 7;
        float st[16];
#pragma unroll
        for (int i = 0; i < 16; ++i) st[i] = 0.f;
        for (int sub = 0; sub < SEQ / 64; ++sub) {
            const int t0 = sub * 64;
            for (int idx = c.tid; idx < 64 * 320; idx += NTHR) {
                const int tl = idx / 320, ch = idx % 320;
                const int gc = ch < 64 ? h * 64 + ch : (ch < 192 ? 2048 + g * 128 + (ch - 64) : 2560 + g * 128 + (ch - 192));
                float acc = cb[gc];
#pragma unroll
                for (int j = 0; j < 4; ++j) { const int tt = t0 + tl - 3 + j; if (tt >= 0) acc += cw[j * CONV_CH + gc] * bf1(XBC[(size_t)(b * SEQ + tt) * CONV_CH + gc]); }
                const float v = acc * sigm(acc);
                if (ch < 64) xL[tl * 64 + ch] = v; else if (ch < 192) BL[tl * 128 + ch - 64] = v; else CL[tl * 128 + ch - 192] = v;
            }
            if (c.tid < 64) dtL[c.tid] = DT[(size_t)(b * SEQ + t0 + c.tid) * SSD_H + h];
            __syncthreads();
            for (int tl = 0; tl < 64; ++tl) {
                const float dtv = dtL[tl], dA = __expf(dtv * Ah), xv = xL[tl * 64 + p], coef = dtv * xv;
                const LAS f32x4* bp = (const LAS f32x4*)(BL + tl * 128 + nq * 16); const LAS f32x4* cp = (const LAS f32x4*)(CL + tl * 128 + nq * 16);
                float ys = 0.f;
#pragma unroll
                for (int i = 0; i < 4; ++i) { const f32x4 bv = bp[i], cv = cp[i];
#pragma unroll
                    for (int k = 0; k < 4; ++k) { st[4 * i + k] = st[4 * i + k] * dA + coef * bv[k]; ys += cv[k] * st[4 * i + k]; } }
                ys += __shfl_xor(ys, 1); ys += __shfl_xor(ys, 2); ys += __shfl_xor(ys, 4);
                if (nq == 0) yL[tl * 64 + p] = ys + Dh * xv;
            }
            __syncthreads();
#pragma unroll
            for (int i = 0; i < 8; ++i) { const int idx = c.tid + NTHR * i, tl = idx >> 6, pp = idx & 63; const size_t t = (size_t)(b * SEQ + t0 + tl);
                bf16* zp = Z + t * SSD_INNER + h * 64 + pp; const float yp = yL[tl * 64 + pp] * bf1(*zp); const bf16 yb = (bf16)f2bf(yp); *zp = yb;
                const float yr = bf1(yb); const float sq = wave_sum(yr * yr); if (c.lane == 0) SSQP[t * SSD_H + h] = sq; }
            __syncthreads();
        }
    }
}
__device__ __forceinline__ void ph_ssd_final(const Args& a, const Ctx& c) {
    const int gw = c.vcu * NWAVES + c.wave, NGW = c.G * NWAVES; bf16* Y = (bf16*)a.out; const float* SSQP = (const float*)(a.ws + WS_SSQP); const float* ng = a.in[I_SSD_NORM];
    for (int m = gw; m < M; m += NGW) {
#pragma unroll
        for (int g = 0; g < 4; ++g) { float ss = 0.f;
#pragma unroll
            for (int i = 0; i < 8; ++i) ss += SSQP[(size_t)m * SSD_H + g * 8 + i];
            const float r = 1.0f / sqrtf(ss * (1.0f / 512.0f) + EPS);
            GAS v4u* yp = (GAS v4u*)(Y + (size_t)m * SSD_INNER + g * 512) + c.lane; const v4u w = *yp; const GAS f32x4* gp = (const GAS f32x4*)(ng + g * 512 + 8 * c.lane); const f32x4 g0 = gp[0], g1 = gp[1];
            v4u o; o.x = pk2(bflo(w.x) * r * g0.x, bfhi(w.x) * r * g0.y); o.y = pk2(bflo(w.y) * r * g0.z, bfhi(w.y) * r * g0.w); o.z = pk2(bflo(w.z) * r * g1.x, bfhi(w.z) * r * g1.y); o.w = pk2(bflo(w.w) * r * g1.z, bfhi(w.w) * r * g1.w);
            *yp = o; }
    }
}

#ifndef ATTN_SIMPLE
#define ATTN_SIMPLE 0
#endif
__global__ void __launch_bounds__(NTHR, 2) skel_fwd(Args args) {
    extern __shared__ __attribute__((aligned(16))) unsigned char lds[];
    Ctx c;
    c.lds = (LAS unsigned char*)lds;
    volatile LAS unsigned* MISC = (volatile LAS unsigned*)(c.lds + MISC_OFF);
    c.tid = threadIdx.x; c.lane = c.tid & 63; c.wave = __builtin_amdgcn_readfirstlane(c.tid >> 6);
    c.G = gridDim.x; { const int bx = blockIdx.x; c.vcu = (c.G % 8 == 0) ? (bx % 8) * (c.G / 8) + bx / 8 : bx; }
    unsigned char* ws = args.ws;
    gu32* ctl = (gu32*)(ws + WS_CTL);
    for (int u = c.tid; u < (LDS_BYTES - LDSCTL_OFF) / 4; u += NTHR) ((LAS unsigned*)(c.lds + LDSCTL_OFF))[u] = 0u;
    __syncthreads();
    const int lo = args.ph_lo, hi = args.ph_hi;
    XcdBarrier bar; bar.bar = (unsigned*)(ctl + CW_BAR); bar.x = 0; bar.st = nullptr;
    if (hi - lo > 1) bar = xcd_barrier_post((unsigned*)(ctl + CW_BAR), MISC + 8);
#define IN(k) (lo <= (k) && (k) < hi)
#define SEAM(k) do { if (IN(k) && IN((k) + 1)) xcd_barrier(bar); } while (0)
    using namespace pg8;
    LAS unsigned char* ring = c.lds + RING_OFF;
    const bf16_t* XN = (const bf16_t*)(ws + WS_XN);

    if (IN(0)) { ph_prologue(args, c); } SEAM(0);
    if (IN(1)) { Gemm g{XN, (const bf16_t*)(ws + WS_WGU), M, 2 * FF, D}; StaticOrder S; S.init(M, 2 * FF, c.G, (int)blockIdx.x); EpiSwiGLU E{(bf16_t*)(ws + WS_H), FF};
        gemm_phase<EpiSwiGLU, StaticOrder, true, true>(ring, g, S, E); } SEAM(1);
    if (IN(2)) { Gemm g{(const bf16_t*)(ws + WS_H), (const bf16_t*)(ws + WS_WD), M, D, FF}; StaticOrder S; S.init(M, D, c.G, (int)blockIdx.x); EpiF32 E{args.out, D};
        gemm_phase<EpiF32, StaticOrder, true, true>(ring, g, S, E); } SEAM(2);
    if (IN(3)) { ph_e2(args, c); } SEAM(3);
    if (IN(4)) { Gemm g{XN, (const bf16_t*)(ws + WS_WQKV), M, 3 * D, D}; StaticOrder S; S.init(M, 3 * D, c.G, (int)blockIdx.x);
        EpiRow8<OpQKV> E{{(bf16_t*)(ws + WS_Q), (WS_K - WS_Q) / 2, QSCALE}};
        gemm_phase<EpiRow8<OpQKV>, StaticOrder, true, true>(ring, g, S, E); } SEAM(4);
#if ATTN_SIMPLE
    if (IN(5)) { ph_attn_simple(args, c); } SEAM(5);
#else
    if (IN(5)) { const attn_body::AttnTensors AT{(const attn_body::bf16*)(ws + WS_Q), (const attn_body::bf16*)(ws + WS_K), (const attn_body::bf16*)(ws + WS_V), (attn_body::bf16*)args.out};
        const attn_body::StaticOrder S((int)c.G, (int)blockIdx.x);
        attn_body::attn_phase<attn_body::StaticOrder>((char*)lds + RING_OFF, AT, S); } SEAM(5);
#endif
    if (IN(6)) { ph_attn_final(args, c); } SEAM(6);
    if (IN(7)) { Gemm g{XN, (const bf16_t*)(ws + WS_WZX), M, 5120, D}; StaticOrder S; S.init(M, 5120, c.G, (int)blockIdx.x);
        EpiRow8<OpZX> E{{(bf16_t*)args.out, (bf16_t*)(ws + WS_XBC)}};
        gemm_phase<EpiRow8<OpZX>, StaticOrder, true, true>(ring, g, S, E);
        ph_dt(args, c); } SEAM(7);
    if (IN(8)) { ph_ssd_simple(args, c); } SEAM(8);
    if (IN(9)) { ph_ssd_final(args, c); } SEAM(9);
    if (IN(10)) { Gemm g{XN, (const bf16_t*)(ws + WS_WGATE), M, 2 * D, D}; StaticOrder S; S.init(M, 2 * D, c.G, (int)blockIdx.x);
        EpiRow8<OpGate> E{{(bf16_t*)(ws + WS_GATES), args.in[I_GATE_B]}};
        gemm_phase<EpiRow8<OpGate>, StaticOrder, true, true>(ring, g, S, E); } SEAM(10);
    if (IN(11)) { Gemm g{(const bf16_t*)args.out, (const bf16_t*)(ws + WS_WSSD), M, D, SSD_INNER}; StaticOrder S; S.init(M, D, c.G, (int)blockIdx.x);
        EpiRow8<OpMerge<true>> E{{(bf16_t*)(ws + WS_MERGED), (const bf16_t*)(ws + WS_GATES)}};
        gemm_phase<EpiRow8<OpMerge<true>>, StaticOrder, true, true>(ring, g, S, E); } SEAM(11);
    if (IN(12)) { Gemm g{(const bf16_t*)(ws + WS_AN), (const bf16_t*)(ws + WS_WDA), M, D, D}; StaticOrder S; S.init(M, D, c.G, (int)blockIdx.x);
        EpiRow8<OpMerge<false>> E{{(bf16_t*)(ws + WS_MERGED), (const bf16_t*)(ws + WS_GATES)}};
        gemm_phase<EpiRow8<OpMerge<false>>, StaticOrder, true, true>(ring, g, S, E); } SEAM(12);
    if (IN(13)) { Gemm g{(const bf16_t*)(ws + WS_MERGED), (const bf16_t*)(ws + WS_WOUT), M, D, D}; StaticOrder S; S.init(M, D, c.G, (int)blockIdx.x); EpiF32 E{args.out, D};
        gemm_phase<EpiF32, StaticOrder, true, true>(ring, g, S, E); } SEAM(13);
    if (IN(14)) { ph_e8(args, c); } SEAM(14);
    if (IN(15)) { Gemm g{XN, (const bf16_t*)(ws + WS_WGU), M, 2 * FF, D}; StaticOrder S; S.init(M, 2 * FF, c.G, (int)blockIdx.x); EpiSwiGLU E{(bf16_t*)(ws + WS_H), FF};
        gemm_phase<EpiSwiGLU, StaticOrder, true, true>(ring, g, S, E); } SEAM(15);
    if (IN(16)) { Gemm g{(const bf16_t*)(ws + WS_H), (const bf16_t*)(ws + WS_WD), M, D, FF}; StaticOrder S; S.init(M, D, c.G, (int)blockIdx.x); EpiF32 E{(float*)(ws + WS_TMP), D};
        gemm_phase<EpiF32, StaticOrder, true, true>(ring, g, S, E); } SEAM(16);
    if (IN(17)) { ph_e10(args, c); }
#undef IN
#undef SEAM
}

#ifndef MK_ONE_LAUNCH
#define MK_ONE_LAUNCH 1
#endif
extern "C" void kernel_launch(void* const* d_in, const int* in_sizes, int n_in, void* d_out, int out_size, void* d_ws, size_t ws_size, hipStream_t stream) {
    static int grid = 0;
    if (grid == 0) {
        if (n_in != N_INPUTS || in_sizes[0] != M * D || out_size != M * D || ws_size < WS_END) { fprintf(stderr, "kernel_launch: unexpected shapes (n_in %d, in0 %d, out %d, ws %zu); nothing launched\n", n_in, n_in > 0 ? in_sizes[0] : -1, out_size, ws_size); grid = -1; return; }
        int dev = 0, cus = 0, per_cu = 0;
        if (hipGetDevice(&dev) != hipSuccess || hipDeviceGetAttribute(&cus, hipDeviceAttributeMultiprocessorCount, dev) != hipSuccess) { grid = -1; return; }
        if (hipFuncSetAttribute((const void*)skel_fwd, hipFuncAttributeMaxDynamicSharedMemorySize, LDS_BYTES) != hipSuccess) { fprintf(stderr, "kernel_launch: hipFuncSetAttribute failed\n"); grid = -1; return; }
        if (hipOccupancyMaxActiveBlocksPerMultiprocessor(&per_cu, (const void*)skel_fwd, NTHR, LDS_BYTES) != hipSuccess || per_cu < 1) fprintf(stderr, "kernel_launch: occupancy query reports %d\n", per_cu);
        (void)hipGetLastError();
        grid = cus;
    }
    if (grid < 0) return;
    (void)hipMemsetAsync((char*)d_ws + WS_CTL, 0, CTL_ZERO_BYTES, stream);
    Args a{};
    for (int i = 0; i < N_INPUTS; ++i) a.in[i] = (const float*)d_in[i];
    a.out = (float*)d_out; a.ws = (unsigned char*)d_ws;
#if MK_ONE_LAUNCH
    a.ph_lo = 0; a.ph_hi = NPH;
    hipLaunchKernelGGL(skel_fwd, dim3(grid), dim3(NTHR), LDS_BYTES, stream, a);
#else
    for (int p = 0; p < NPH; ++p) { a.ph_lo = p; a.ph_hi = p + 1; hipLaunchKernelGGL(skel_fwd, dim3(grid), dim3(NTHR), LDS_BYTES, stream, a); }
#endif
}
```

```cpp
#include <hip/hip_runtime.h>
#include <cstdio>
#include <cstdint>
namespace pg8 {
#define PG8_LAS __attribute__((address_space(3)))
typedef unsigned short bf16_t;
typedef short bf16x8 __attribute__((ext_vector_type(8)));
typedef float f32x4 __attribute__((ext_vector_type(4)));
typedef unsigned u32x4 __attribute__((ext_vector_type(4)));
constexpr int BM = 256, BK = 64, HALF = 128, HTB = HALF * BK * 2  , STAGE_BYTES = 8 * HTB, NXCD = 8, WGM = 8;

__host__ __device__ __forceinline__ int lds_byte(int r, int c) { const int st = (r >> 4) * 2 + (c >> 5), rr = r & 15, cc = c & 31, ob = rr * 64 + cc * 2; return st * 1024 + (ob ^ (((ob >> 9) & 1) << 5)); }
__host__ __device__ __forceinline__ void stage_rc(int b, int& R, int& C) { const int st = b / 1024, sb = b % 1024, swz = sb ^ (((sb >> 9) & 1) << 5); R = (st >> 1) * 16 + swz / 64; C = (st & 1) * 32 + (swz % 64) / 2; }
__host__ __device__ __forceinline__ int perm32(int rho) { const int n = rho >> 4, i = rho & 15; return 8 * (i >> 2) + 4 * n + (i & 3); }

struct Unit { int pm, pn; };
struct Gemm { const bf16_t* A; const bf16_t* Bt; int M, N, K; };

struct StaticOrder {
    int nM, nN, nwg, G, c;
    __host__ __device__ void init(int M, int N, int G_, int c_) { nM = M / BM; nN = N / BM; nwg = nM * nN; G = G_; c = c_; }
    __host__ __device__ bool next(int i, Unit& u) const {
        const long L = (long)i * G + c; if (L >= nwg) return false;
        int wgid = (int)L; { const int q = nwg / NXCD, r = nwg % NXCD, xcd = wgid % NXCD, off = wgid / NXCD; wgid = (xcd < r ? xcd * (q + 1) : r * (q + 1) + (xcd - r) * q) + off; }
        const int nig = WGM * nN, gid = wgid / nig, fm = gid * WGM, gsz = (nM - fm) < WGM ? (nM - fm) : WGM;
        u.pm = fm + ((wgid % nig) % gsz); u.pn = (wgid % nig) / gsz; return true;
    }
    __device__ __forceinline__ void a_ready(const Unit&) const {}
    __device__ __forceinline__ void done(const Unit&) const {}
};

__device__ __forceinline__ unsigned cvt_pk_bf16(float lo, float hi) { unsigned r; asm volatile("v_cvt_pk_bf16_f32 %0, %1, %2" : "=v"(r) : "v"(lo), "v"(hi)); return r; }
typedef float f32x2 __attribute__((ext_vector_type(2)));
typedef unsigned u32x2 __attribute__((ext_vector_type(2)));
__device__ __forceinline__ float bf_lo(unsigned w) { return __uint_as_float(w << 16); }
__device__ __forceinline__ float bf_hi(unsigned w) { return __uint_as_float(w & 0xffff0000u); }
__device__ __forceinline__ float sigmoid_f(float x) { return __builtin_amdgcn_rcpf(1.0f + __builtin_amdgcn_exp2f(-1.4426950408889634f * x)); }
__device__ __forceinline__ float silu_f(float x) { return x * sigmoid_f(x); }
__device__ __forceinline__ u32x4 pack8(const f32x4 v0, const f32x4 v1) { u32x4 w; w.x = cvt_pk_bf16(v0[0], v0[1]); w.y = cvt_pk_bf16(v0[2], v0[3]); w.z = cvt_pk_bf16(v1[0], v1[1]); w.w = cvt_pk_bf16(v1[2], v1[3]); return w; }

struct EpiF32 {
    static constexpr bool PERM = false, AFTER_DRAIN = false;
    float* C; int ldc;
    __device__ __forceinline__ void operator()(const f32x4 (&acc)[2][2][4][2], const Unit& u, int wr, int wc, int fr, int fq) const {
        const int row0 = u.pm * BM + wr * 64 + fr, col0 = u.pn * BM + wc * 32 + 4 * fq;
#pragma unroll
        for (int ai = 0; ai < 2; ++ai)
#pragma unroll
            for (int m = 0; m < 4; ++m) { float* rowp = C + (size_t)(row0 + ai * HALF + m * 16) * ldc + col0;
#pragma unroll
                for (int bj = 0; bj < 2; ++bj)
#pragma unroll
                    for (int n = 0; n < 2; ++n) *(f32x4*)(rowp + bj * HALF + n * 16) = acc[ai][bj][m][n]; }
    }
};
struct EpiSwiGLU {
    static constexpr bool PERM = true, AFTER_DRAIN = false;
    bf16_t* O; int ldc;
    __device__ __forceinline__ void operator()(const f32x4 (&acc)[2][2][4][2], const Unit& u, int wr, int wc, int fr, int fq) const {
        const int row0 = u.pm * BM + wr * 64 + fr, col0 = u.pn * HALF + wc * 32 + 8 * fq;
#pragma unroll
        for (int ai = 0; ai < 2; ++ai)
#pragma unroll
            for (int m = 0; m < 4; ++m) { bf16_t* rowp = O + (size_t)(row0 + ai * HALF + m * 16) * ldc + col0;
                f32x4 v0, v1;
#pragma unroll
                for (int j = 0; j < 4; ++j) { v0[j] = silu_f(acc[ai][0][m][0][j]) * acc[ai][1][m][0][j]; v1[j] = silu_f(acc[ai][0][m][1][j]) * acc[ai][1][m][1][j]; }
                *(u32x4*)rowp = pack8(v0, v1); }
    }
};
template <class Op> struct EpiRow8 {
    static constexpr bool PERM = true, AFTER_DRAIN = false;
    Op op;
    __device__ __forceinline__ void operator()(const f32x4 (&acc)[2][2][4][2], const Unit& u, int wr, int wc, int fr, int fq) const {
        const int row0 = u.pm * BM + wr * 64 + fr, tc0 = wc * 32 + 8 * fq;
#pragma unroll
        for (int ai = 0; ai < 2; ++ai)
#pragma unroll
            for (int m = 0; m < 4; ++m)
#pragma unroll
                for (int bj = 0; bj < 2; ++bj) op.st(row0 + ai * HALF + m * 16, tc0 + bj * HALF, u, acc[ai][bj][m][0], acc[ai][bj][m][1]);
    }
};
struct OpQKV { bf16_t* Q; size_t stride; float qscale;
    __device__ __forceinline__ void st(int row, int tc, const Unit& u, f32x4 v0, f32x4 v1) const {
        const int t = u.pn >> 2, col = (u.pn & 3) * BM + tc; const float sc = (t == 0) ? qscale : 1.0f;
        *(u32x4*)(Q + (size_t)t * stride + (size_t)row * 1024 + col) = pack8(v0 * sc, v1 * sc); } };
struct OpZX { bf16_t* Z; bf16_t* XBC;
    __device__ __forceinline__ void st(int row, int tc, const Unit& u, f32x4 v0, f32x4 v1) const {
        if (u.pn < 8) {
#pragma unroll
            for (int j = 0; j < 4; ++j) { v0[j] = silu_f(v0[j]); v1[j] = silu_f(v1[j]); }
            *(u32x4*)(Z + (size_t)row * 2048 + u.pn * BM + tc) = pack8(v0, v1);
        } else *(u32x4*)(XBC + (size_t)row * 3072 + (u.pn - 8) * BM + tc) = pack8(v0, v1); } };
struct OpGate { bf16_t* G; const float* bias;
    __device__ __forceinline__ void st(int row, int tc, const Unit& u, f32x4 v0, f32x4 v1) const {
        const int col = u.pn * BM + tc; const f32x4 b0 = *(const f32x4*)(bias + col), b1 = *(const f32x4*)(bias + col + 4);
#pragma unroll
        for (int j = 0; j < 4; ++j) { v0[j] = sigmoid_f(v0[j] + b0[j]); v1[j] = sigmoid_f(v1[j] + b1[j]); }
        *(u32x4*)(G + (size_t)row * 2048 + col) = pack8(v0, v1); } };
template <bool FIRST> struct OpMerge { bf16_t* Mg; const bf16_t* G;
    __device__ __forceinline__ void st(int row, int tc, const Unit& u, f32x4 v0, f32x4 v1) const {
        const int col = u.pn * BM + tc; const u32x4 g = *(const u32x4*)(G + (size_t)row * 2048 + (FIRST ? 0 : 1024) + col);
        v0[0] *= bf_lo(g.x); v0[1] *= bf_hi(g.x); v0[2] *= bf_lo(g.y); v0[3] *= bf_hi(g.y); v1[0] *= bf_lo(g.z); v1[1] *= bf_hi(g.z); v1[2] *= bf_lo(g.w); v1[3] *= bf_hi(g.w);
        bf16_t* p = Mg + (size_t)row * 1024 + col;
        if (!FIRST) { const u32x4 o = *(const u32x4*)p;
            v0[0] += bf_lo(o.x); v0[1] += bf_hi(o.x); v0[2] += bf_lo(o.y); v0[3] += bf_hi(o.y); v1[0] += bf_lo(o.z); v1[1] += bf_hi(o.z); v1[2] += bf_lo(o.w); v1[3] += bf_hi(o.w); }
        *(u32x4*)p = pack8(v0, v1); } };
template <class Epi, class Sched, bool ALIGN_EPI = false, bool SP2 = false>
__device__ __forceinline__ void gemm_phase(PG8_LAS unsigned char* lds, const Gemm g, const Sched& S, const Epi& E) {
    const int tid = threadIdx.x, wid = __builtin_amdgcn_readfirstlane(tid >> 6), lane = tid & 63, wr = wid >> 2, wc = wid & 3, fr = lane & 15, fq = lane >> 4;
    const int K = g.K, nt = K / BK;
    unsigned voffA[2], voffB[2];
#pragma unroll
    for (int i = 0; i < 2; ++i) { int R, C; stage_rc(tid * 16 + i * 8192, R, C); const int Rb = Epi::PERM ? ((R & ~31) + perm32(R & 31)) : R;
        voffA[i] = (unsigned)(R * K + C) * 2u; voffB[i] = (unsigned)(Rb * K + C) * 2u; }
    const size_t kstep = (size_t)(BK * 2);
    const size_t hstep = (size_t)HALF * K * 2;
    const size_t tstep = 2 * hstep;
    const unsigned ldsw = (unsigned)wid * 1024u;
    const int aoff = lds_byte(wr * 64 + fr, fq * 8), boff = lds_byte(wc * 32 + fr, fq * 8);
#define PG8_SA(b, h) (((b) * 2 + (h)) * HTB)
#define PG8_SB(b, h) ((4 + (b) * 2 + (h)) * HTB)
#define PG8_STAGE(bufoff, gbase, voff) do { _Pragma("unroll") for (int _i = 0; _i < 2; ++_i) \
        __builtin_amdgcn_global_load_lds((const unsigned*)((const char*)(gbase) + (voff)[_i]), (PG8_LAS unsigned*)(lds + (bufoff) + ldsw + _i * 8192), 16, 0, 0); } while (0)
#define PG8_LDA(dst, b, h) do { _Pragma("unroll") for (int m = 0; m < 4; ++m) _Pragma("unroll") for (int k = 0; k < 2; ++k) dst[m][k] = *(const PG8_LAS bf16x8*)(lds + PG8_SA(b, h) + aoff + m * 2048 + k * 1024); } while (0)
#define PG8_LDB(dst, b, h) do { _Pragma("unroll") for (int n = 0; n < 2; ++n) _Pragma("unroll") for (int k = 0; k < 2; ++k) dst[n][k] = *(const PG8_LAS bf16x8*)(lds + PG8_SB(b, h) + boff + n * 2048 + k * 1024); } while (0)
#define PG8_MMA(ai, bj, At, Bt) do { __builtin_amdgcn_s_setprio(1); _Pragma("unroll") for (int m = 0; m < 4; ++m) _Pragma("unroll") for (int n = 0; n < 2; ++n) _Pragma("unroll") for (int k = 0; k < 2; ++k) \
        acc[ai][bj][m][n] = __builtin_amdgcn_mfma_f32_16x16x32_bf16(Bt[n][k], At[m][k], acc[ai][bj][m][n], 0, 0, 0); __builtin_amdgcn_s_setprio(0); } while (0)
#define PG8_WAIT_V(n) asm volatile("s_waitcnt vmcnt(" #n ")" ::: "memory")
#define PG8_WAIT_L(n) asm volatile("s_waitcnt lgkmcnt(" #n ")" ::: "memory")
#define PG8_BAR __builtin_amdgcn_s_barrier()
#define PG8_SCHED __builtin_amdgcn_sched_barrier(0)
    Unit cur, nxt; int ui = 0;
    if (!S.next(0, cur)) return;
    f32x4 acc[2][2][4][2];
#pragma unroll
    for (int a = 0; a < 2; ++a)
#pragma unroll
        for (int b = 0; b < 2; ++b)
#pragma unroll
            for (int m = 0; m < 4; ++m)
#pragma unroll
                for (int n = 0; n < 2; ++n) acc[a][b][m][n] = (f32x4){0.f, 0.f, 0.f, 0.f};
    bf16x8 At[4][2], B0[2][2], B1[2][2];
    const char* cA = (const char*)g.A + (size_t)cur.pm * tstep; const char* cB = (const char*)g.Bt + (size_t)cur.pn * tstep;
    S.a_ready(cur);
    if constexpr (SP2) {
        PG8_STAGE(PG8_SB(0, 0), cB, voffB); PG8_STAGE(PG8_SB(0, 1), cB + hstep, voffB); PG8_STAGE(PG8_SA(0, 0), cA, voffA); PG8_STAGE(PG8_SA(0, 1), cA + hstep, voffA);
        if (wr == 1) PG8_BAR;
        PG8_WAIT_V(2); PG8_BAR;
        PG8_STAGE(PG8_SB(1, 0), cB + kstep, voffB); PG8_STAGE(PG8_SA(1, 0), cA + kstep, voffA); PG8_STAGE(PG8_SB(1, 1), cB + hstep + kstep, voffB);
        PG8_WAIT_V(6); PG8_BAR;
    } else {
        PG8_STAGE(PG8_SB(0, 0), cB, voffB); PG8_STAGE(PG8_SA(0, 0), cA, voffA); PG8_STAGE(PG8_SB(0, 1), cB + hstep, voffB); PG8_STAGE(PG8_SA(0, 1), cA + hstep, voffA);
        if (wr == 1) PG8_BAR;
        PG8_WAIT_V(4); PG8_BAR;
        PG8_STAGE(PG8_SB(1, 0), cB + kstep, voffB); PG8_STAGE(PG8_SA(1, 0), cA + kstep, voffA); PG8_STAGE(PG8_SB(1, 1), cB + hstep + kstep, voffB);
        PG8_WAIT_V(6); PG8_BAR;
    }
    for (;;) {
        const bool has_next = S.next(ui + 1, nxt);
        const char* nA = has_next ? (const char*)g.A + (size_t)nxt.pm * tstep : cA; const char* nB = has_next ? (const char*)g.Bt + (size_t)nxt.pn * tstep : cB;
        for (int t = 0; t < nt; t += 2) {
            const bool last = (t == nt - 2);
            const char* a1 = cA + (size_t)(t + 1) * kstep;
            const char* a2 = last ? nA : cA + (size_t)(t + 2) * kstep; const char* b2 = last ? nB : cB + (size_t)(t + 2) * kstep;
            const char* a3 = a2 + kstep; const char* b3 = b2 + kstep;
            if (last && has_next) S.a_ready(nxt);
            if constexpr (SP2) {
            PG8_LDB(B0, 0, 0); PG8_LDB(B1, 0, 1); PG8_SCHED; PG8_LDA(At, 0, 0); PG8_STAGE(PG8_SA(1, 1), a1 + hstep, voffA);
            PG8_WAIT_V(8); PG8_WAIT_L(0); PG8_BAR; PG8_MMA(0, 0, At, B0); PG8_MMA(0, 1, At, B1); PG8_BAR; PG8_SCHED;
            PG8_LDA(At, 0, 1); PG8_STAGE(PG8_SB(0, 0), b2, voffB); PG8_STAGE(PG8_SB(0, 1), b2 + hstep, voffB); PG8_STAGE(PG8_SA(0, 0), a2, voffA);
            PG8_WAIT_V(8); PG8_WAIT_L(0); PG8_BAR; PG8_MMA(1, 0, At, B0); PG8_MMA(1, 1, At, B1); PG8_BAR; PG8_SCHED;
            PG8_LDB(B0, 1, 0); PG8_LDB(B1, 1, 1); PG8_SCHED; PG8_LDA(At, 1, 0); PG8_STAGE(PG8_SA(0, 1), a2 + hstep, voffA);
            PG8_WAIT_V(8); PG8_WAIT_L(0); PG8_BAR; PG8_MMA(0, 0, At, B0); PG8_MMA(0, 1, At, B1); PG8_BAR; PG8_SCHED;
            PG8_LDA(At, 1, 1); PG8_STAGE(PG8_SB(1, 0), b3, voffB); PG8_STAGE(PG8_SB(1, 1), b3 + hstep, voffB); PG8_STAGE(PG8_SA(1, 0), a3, voffA);
            PG8_WAIT_V(8); PG8_WAIT_L(0); PG8_BAR; PG8_MMA(1, 0, At, B0); PG8_MMA(1, 1, At, B1); PG8_BAR; PG8_SCHED;
            } else {
            PG8_LDB(B0, 0, 0); PG8_SCHED; PG8_LDA(At, 0, 0); PG8_STAGE(PG8_SA(1, 1), a1 + hstep, voffA);
            PG8_WAIT_L(8); PG8_BAR; PG8_WAIT_L(0); PG8_MMA(0, 0, At, B0); PG8_BAR; PG8_SCHED;
            PG8_LDB(B1, 0, 1); PG8_STAGE(PG8_SB(0, 0), b2, voffB);
            PG8_BAR; PG8_WAIT_L(0); PG8_MMA(0, 1, At, B1); PG8_BAR;
            PG8_LDA(At, 0, 1); PG8_STAGE(PG8_SA(0, 0), a2, voffA);
            PG8_BAR; PG8_WAIT_L(0); PG8_MMA(1, 0, At, B0); PG8_BAR; PG8_SCHED;
            PG8_STAGE(PG8_SB(0, 1), b2 + hstep, voffB);
            PG8_WAIT_V(6); PG8_BAR; PG8_MMA(1, 1, At, B1); PG8_BAR;
            PG8_LDB(B0, 1, 0); PG8_SCHED; PG8_LDA(At, 1, 0); PG8_STAGE(PG8_SA(0, 1), a2 + hstep, voffA);
            PG8_WAIT_L(8); PG8_BAR; PG8_WAIT_L(0); PG8_MMA(0, 0, At, B0); PG8_BAR; PG8_SCHED;
            PG8_LDB(B1, 1, 1); PG8_STAGE(PG8_SB(1, 0), b3, voffB);
            PG8_BAR; PG8_WAIT_L(0); PG8_MMA(0, 1, At, B1); PG8_BAR;
            PG8_LDA(At, 1, 1); PG8_STAGE(PG8_SA(1, 0), a3, voffA);
            PG8_BAR; PG8_WAIT_L(0); PG8_MMA(1, 0, At, B0); PG8_BAR; PG8_SCHED;
            PG8_STAGE(PG8_SB(1, 1), b3 + hstep, voffB);
            PG8_WAIT_V(6); PG8_BAR; PG8_MMA(1, 1, At, B1); PG8_BAR;
            }
        }
        if constexpr (ALIGN_EPI) { if (wr == 0) PG8_BAR; }
        if constexpr (!Epi::AFTER_DRAIN) { E(acc, cur, wr, wc, fr, fq); S.done(cur); }
        if (!has_next) break;
#pragma unroll
        for (int a = 0; a < 2; ++a)
#pragma unroll
            for (int b = 0; b < 2; ++b)
#pragma unroll
                for (int m = 0; m < 4; ++m)
#pragma unroll
                    for (int n = 0; n < 2; ++n) acc[a][b][m][n] = (f32x4){0.f, 0.f, 0.f, 0.f};
        cur = nxt; cA = nA; cB = nB; ++ui;
        if constexpr (ALIGN_EPI) { if (wr == 1) PG8_BAR; }
    }
    PG8_WAIT_V(0);
    if constexpr (!ALIGN_EPI) { if (wr == 0) PG8_BAR; }
    PG8_BAR;
    if constexpr (Epi::AFTER_DRAIN) { E.fused(acc, cur, wr, wc, fr, fq, lds, wid, lane); S.done(cur); }
#undef PG8_SA
#undef PG8_SB
#undef PG8_STAGE
#undef PG8_LDA
#undef PG8_LDB
#undef PG8_MMA
#undef PG8_WAIT_V
#undef PG8_WAIT_L
#undef PG8_BAR
#undef PG8_SCHED
}
}
#include <hip/hip_bf16.h>
#include <cmath>
namespace attn_body {
using bf16=__hip_bfloat16;
using bf16x8=__attribute__((ext_vector_type(8)))short;
using s16x4=__attribute__((ext_vector_type(4)))short;
using f32x16=__attribute__((ext_vector_type(16)))float;
using u32x4=__attribute__((ext_vector_type(4)))unsigned;
constexpr int BATCH=8,NHEAD=16,SEQ=2048,D=64,DM=NHEAD*D,OPITCH=2048;
constexpr int NW=8,QBLK=32,QB=QBLK*NW,KVBLK=64,NQB=SEQ/QB;
constexpr int ATTN_PITCH=DM, ATTN_UNIT_ROWS=QB;
__device__ __forceinline__ int crow(int r,int hi){return (r&3)+8*(r>>2)+4*hi;}
#define SBAR() __builtin_amdgcn_sched_barrier(0)
__device__ __forceinline__ void cmask(f32x16&p0,f32x16&p1,int jb,int qrel,int hi){
  const float NEG=-INFINITY; int kb=64*jb+4*hi;
  #pragma unroll
  for(int r=0;r<16;++r){int kv=kb+(r&3)+8*(r>>2); if(kv>qrel)p0[r]=NEG; if(kv+32>qrel)p1[r]=NEG;}
}

constexpr int NSLOT=3, SLOTB=8192;
constexpr int LDS_K=0, LDS_V=NSLOT*SLOTB, LDS_WS=2*NSLOT*SLOTB, LDS_OST=LDS_WS+NW*64*4, LDS_BYTES=LDS_OST+NW*4096;
constexpr float C2=0.125f*1.4426950408889634f;
__device__ __forceinline__ void glds16(const void*gsrc,unsigned lds_dst){unsigned keep;
  asm volatile("s_mov_b32 %0, m0\n\ts_mov_b32 m0, %2\n\ts_nop 0\n\tglobal_load_lds_dwordx4 %1, off\n\ts_mov_b32 m0, %0":"=&s"(keep):"v"(gsrc),"s"(lds_dst):"memory");}
__device__ __forceinline__ float max3f(float a,float b,float c){float r;asm("v_max3_f32 %0, %1, %2, %3":"=v"(r):"v"(a),"v"(b),"v"(c));return r;}
__device__ __forceinline__ float max2f(float a,float b){float r;asm("v_max_f32_e32 %0, %1, %2":"=v"(r):"v"(a),"v"(b));return r;}
__device__ __forceinline__ float fadd_s(float a,float b){float r;asm("v_add_f32_e32 %0, %1, %2":"=v"(r):"v"(a),"v"(b));return r;}
__device__ __forceinline__ float fsub_s(float a,float b){float r;asm("v_sub_f32_e32 %0, %1, %2":"=v"(r):"v"(a),"v"(b));return r;}
typedef float f32x2_t __attribute__((ext_vector_type(2))); typedef __bf16 bf16x2_t __attribute__((ext_vector_type(2)));
__device__ __forceinline__ unsigned cvtpk_s(float lo,float hi){f32x2_t v={lo,hi};bf16x2_t b=__builtin_convertvector(v,bf16x2_t);return __builtin_bit_cast(unsigned,b);}
#define WAIT_BAR(N) asm volatile("s_waitcnt vmcnt(" #N ") lgkmcnt(0)\n\ts_barrier":::"memory")

__device__ __forceinline__ void qkt(f32x16&p0,f32x16&p1,const char*Kslot,const bf16x8*qr,const f32x16&negm,int r32,int hi,bf16x8 ka0,bf16x8 ka1,bf16x8 qaug){
  const char*kb=Kslot+hi*1024+r32*16;
  #pragma unroll
  for(int d0=0;d0<4;++d0){
    const bf16x8 b0=*reinterpret_cast<const bf16x8*>(kb+d0*2048);
    const bf16x8 b1=*reinterpret_cast<const bf16x8*>(kb+d0*2048+512);
    if(d0==0){p0=__builtin_amdgcn_mfma_f32_32x32x16_bf16(b0,qr[0],negm,0,0,0);p1=__builtin_amdgcn_mfma_f32_32x32x16_bf16(b1,qr[0],negm,0,0,0);}
    else{p0=__builtin_amdgcn_mfma_f32_32x32x16_bf16(b0,qr[d0],p0,0,0,0);p1=__builtin_amdgcn_mfma_f32_32x32x16_bf16(b1,qr[d0],p1,0,0,0);}}
  p0=__builtin_amdgcn_mfma_f32_32x32x16_bf16(ka0,qaug,p0,0,0,0);p1=__builtin_amdgcn_mfma_f32_32x32x16_bf16(ka1,qaug,p1,0,0,0);
}
typedef __attribute__((address_space(3))) const char* lds_cptr;
typedef short v4i16_t __attribute__((ext_vector_type(4)));
__device__ __forceinline__ void kload8(bf16x8*kf,lds_cptr kp){
  kf[0]=*(const __attribute__((address_space(3))) bf16x8*)(kp);      kf[1]=*(const __attribute__((address_space(3))) bf16x8*)(kp+512);
  kf[2]=*(const __attribute__((address_space(3))) bf16x8*)(kp+2048); kf[3]=*(const __attribute__((address_space(3))) bf16x8*)(kp+2560);
  kf[4]=*(const __attribute__((address_space(3))) bf16x8*)(kp+4096); kf[5]=*(const __attribute__((address_space(3))) bf16x8*)(kp+4608);
  kf[6]=*(const __attribute__((address_space(3))) bf16x8*)(kp+6144); kf[7]=*(const __attribute__((address_space(3))) bf16x8*)(kp+6656);
}
__device__ __forceinline__ void kload2(bf16x8*kf,lds_cptr kp,int j){ kf[2*j]=*(const __attribute__((address_space(3))) bf16x8*)(kp+j*2048); kf[2*j+1]=*(const __attribute__((address_space(3))) bf16x8*)(kp+j*2048+512); }
__device__ __forceinline__ s16x4 vtr(lds_cptr p){ return __builtin_bit_cast(s16x4,__builtin_amdgcn_ds_read_tr16_b64_v4i16((__attribute__((address_space(3))) v4i16_t*)p)); }
__device__ __forceinline__ float rowmax(const f32x16&p0,const f32x16&p1){
  float a=max3f(p0[0],p0[1],p1[0]),b=max3f(p0[2],p0[3],p1[1]);a=max3f(a,p1[2],p1[3]);
  #pragma unroll
  for(int r=4;r<16;r+=4){a=max3f(a,p0[r],p0[r+1]);b=max3f(b,p0[r+2],p0[r+3]);a=max3f(a,p1[r],p1[r+1]);b=max3f(b,p1[r+2],p1[r+3]);}
  const float m=max2f(a,b);
  auto rr=__builtin_amdgcn_permlane32_swap(__float_as_uint(m),__float_as_uint(m),false,false);
  return max2f(__uint_as_float(rr[0]),__uint_as_float(rr[1]));
}
__device__ __forceinline__ void pv(f32x16*o,int vb,bf16x8 pa0,bf16x8 pa1,bf16x8 pa2,bf16x8 pa3){
  #pragma unroll
  for(int d0=0;d0<2;++d0){s16x4 lo[4],hi[4];
    #pragma unroll
    for(int ks=0;ks<4;++ks){
      asm volatile("ds_read_b64_tr_b16 %0,%1 offset:%c2":"=&v"(lo[ks]):"v"(vb),"i"(d0*4096+ks*1024):"memory");
      asm volatile("ds_read_b64_tr_b16 %0,%1 offset:%c2":"=&v"(hi[ks]):"v"(vb),"i"(d0*4096+ks*1024+512):"memory");}
    asm volatile("s_waitcnt lgkmcnt(0)":::"memory");SBAR();
    #define PK(k) (bf16x8){lo[k][0],lo[k][1],lo[k][2],lo[k][3],hi[k][0],hi[k][1],hi[k][2],hi[k][3]}
    o[d0]=__builtin_amdgcn_mfma_f32_32x32x16_bf16(pa0,PK(0),o[d0],0,0,0);
    o[d0]=__builtin_amdgcn_mfma_f32_32x32x16_bf16(pa1,PK(1),o[d0],0,0,0);
    o[d0]=__builtin_amdgcn_mfma_f32_32x32x16_bf16(pa2,PK(2),o[d0],0,0,0);
    o[d0]=__builtin_amdgcn_mfma_f32_32x32x16_bf16(pa3,PK(3),o[d0],0,0,0);
    #undef PK
  }
}

#ifndef ATTN_STORE16
#define ATTN_STORE16(p,v) (*(u32x4*)(p)=(v))
#endif
template<int THRL> __device__ __forceinline__ void attn_unit(int b,int hm,int vh,int qb,const bf16*Q,const bf16*__restrict__ K,const bf16*__restrict__ V,bf16*O,char*shm){
  const int tid=threadIdx.x,lane=tid&63,r32=lane&31,hi=lane>>5; const int wid=__builtin_amdgcn_readfirstlane(tid>>6);
  const long rowbase=(long)b*SEQ; const int q0=qb*QB;
  const bf16*Qw=Q+(rowbase+q0+wid*QBLK)*DM+hm*D;
  const bf16*Kh=K+rowbase*DM+hm*D,*Vh=V+rowbase*DM+(hm>>1)*128+vh*D;
  bf16x8 qaug, ka0, ka1; unsigned kaw1;
  { const float sl2=__builtin_amdgcn_exp2f(-(float)((hm>>1)+1))*1.4426950408889634f; const unsigned shb=__float_as_uint(sl2)&0xffff0000u; const float shi=__uint_as_float(shb); const float slo=sl2-shi;
    const unsigned b_shi=shb>>16, b_slo=(__float_as_uint(slo)+0x7fffu+((__float_as_uint(slo)>>16)&1u))>>16, b_shi32=__float_as_uint(shi*32.f)>>16, b_slo32=__float_as_uint(__uint_as_float(b_slo<<16)*32.f)>>16;
    u32x4 qa={hi?0u:(b_shi32|(b_slo32<<16)), hi?0u:(b_shi|(b_slo<<16)), 0u, 0u}; qaug=__builtin_bit_cast(bf16x8,qa);
    const unsigned rb=__float_as_uint((float)r32)>>16; kaw1=hi?0u:(rb|(rb<<16)); }
  #define KAUG(dst,a_) do{ const unsigned ab_=__float_as_uint((float)(a_))>>16; u32x4 kq_={hi?0u:(ab_|(ab_<<16)), kaw1, 0u, 0u}; dst=__builtin_bit_cast(bf16x8,kq_); }while(0)
  const unsigned lds0=(unsigned)(uintptr_t)shm;
  float*wsf=(float*)(shm+LDS_WS)+wid*64;
  const bf16*ksrc=Kh+(long)lane*DM+wid*8;
  const bf16*vsrc=Vh+(long)(16*(wid&3)+(lane>>2))*DM+(wid>>2)*32+(lane&3)*8;
  const unsigned kdst=lds0+LDS_K+wid*1024, vdst=lds0+LDS_V+wid*1024;
  #define DMA_K(t,slot) glds16(ksrc+(long)(t)*KVBLK*DM,(unsigned)__builtin_amdgcn_readfirstlane(kdst+(slot)))
  #define DMA_V(t,slot) glds16(vsrc+(long)(t)*KVBLK*DM,(unsigned)__builtin_amdgcn_readfirstlane(vdst+(slot)))
  const int vb0=(int)(lds0+LDS_V)+((lane>>4)&1)*32+(lane&3)*8+(4*hi+((lane&15)>>2))*64;
  const char*Kbase=shm+LDS_K; bf16x8 kf[8];
  const lds_cptr shm3=(lds_cptr)shm; const lds_cptr kp0=shm3+LDS_K+hi*1024+r32*16; const lds_cptr vp0=shm3+LDS_V+((lane>>4)&1)*32+(lane&3)*8+(4*hi+((lane&15)>>2))*64;
  const int NT=(q0+QB)/KVBLK;
  DMA_K(0,0);DMA_V(0,0);DMA_K(1,SLOTB);
  bf16x8 qr[4];
  #pragma unroll
  for(int d0=0;d0<4;++d0)qr[d0]=*reinterpret_cast<const bf16x8*>(&Qw[(long)r32*DM+d0*16+hi*8]);
  float mhat=0.f,l_reg=0.f;f32x16 o[2];o[0]=f32x16{};o[1]=f32x16{};f32x16 negm=f32x16{};asm volatile("":"+v"(negm));
  const int qrel=wid*QBLK+r32;
  #define CMASK(P0,P1,t) do{int jb_=(t)-(NT-4); if(jb_>=0)cmask(P0,P1,jb_,qrel,hi);}while(0)
  bool resc=false;
  #define START(P0,P1) do{ const float rm=rowmax(P0,P1); resc=false; \
    { const float dl=rm; mhat=fadd_s(mhat,dl); \
      _Pragma("unroll") for(int r=0;r<16;++r){P0[r]=fsub_s(P0[r],dl);P1[r]=fsub_s(P1[r],dl);} \
      _Pragma("unroll") for(int r=0;r<16;++r)negm[r]=-mhat; asm volatile("":"+v"(negm)); } \
    _Pragma("unroll") for(int r=0;r<16;++r)P0[r]=__builtin_amdgcn_exp2f(P0[r]); }while(0)
  #define RESC() do{ if(resc){ asm volatile("s_waitcnt lgkmcnt(0)":::"memory"); \
      _Pragma("unroll") for(int d_=0;d_<2;++d_) _Pragma("unroll") for(int r=0;r<16;++r)o[d_][r]*=wsf[crow(r,hi)]; } }while(0)
  f32x16 pA0,pA1,pB0,pB1;
  int sl_prev=0,sl_cur=0,sl_next=SLOTB;
  #define ROT() do{sl_prev=sl_cur;sl_cur=sl_next;sl_next=(sl_next==(NSLOT-1)*SLOTB)?0:sl_next+SLOTB;}while(0)
  DMA_K(2,2*SLOTB);
  WAIT_BAR(3);
  KAUG(ka0,0); KAUG(ka1,1);
  qkt(pA0,pA1,Kbase,qr,negm,r32,hi,ka0,ka1,qaug);asm volatile("s_nop 15\n\ts_nop 7":"+v"(pA0),"+v"(pA1));CMASK(pA0,pA1,0);
  START(pA0,pA1);
  _Pragma("unroll") for(int r=0;r<16;++r)pA1[r]=__builtin_amdgcn_exp2f(pA1[r]);
  WAIT_BAR(0);
  DMA_K(3,0);DMA_V(1,SLOTB);
  ROT();
  kload8(kf,kp0+sl_cur);
  WAIT_BAR(2);
  s16x4 vlo[8],vhi[8]; u32x4 pw0,pw1,pw2,pw3;
  #define PKW(P,B) cvtpk_s(P[B],P[B+1])
  #define PAF(k) __builtin_bit_cast(bf16x8,pw##k)
  #define VFR(i) (bf16x8){vlo[i][0],vlo[i][1],vlo[i][2],vlo[i][3],vhi[i][0],vhi[i][1],vhi[i][2],vhi[i][3]}
  #define PIN(x) asm volatile("":"+v"(x))
  #define MX3(a,b,c) __builtin_fmaxf(__builtin_fmaxf((a),(b)),(c))
  #define GAPA(MF,A0,A1,A2,A3,W0,W1,PW) do{ MF; sacc+=A0; sacc+=A1; sacc+=A2; sacc+=A3; PIN(sacc); W0; W1; PIN(PW); SBAR(); }while(0)
  #define EX(v) __builtin_amdgcn_exp2f(v)
  #define GAPB(MF,X,B) do{ MF; X[B]=EX(X[B]); X[B+1]=EX(X[B+1]); X[B+2]=EX(X[B+2]); X[B+3]=EX(X[B+3]); PIN(X); SBAR(); }while(0)
  #define VRD(i) do{ vlo[i]=vtr(vp_+(((i)>>2)*4096+((i)&3)*1024)); vhi[i]=vtr(vp_+(((i)>>2)*4096+((i)&3)*1024+512)); }while(0)
  #define KRD(G,j) do{ if(G){ kload2(kf,kp0+sl_next,j); SBAR(); } }while(0)
  #define STEP(C0,C1,P0,P1,t,GK,GV,GL) do{ SBAR(); \
    const lds_cptr vp_=vp0+sl_prev; \
    VRD(0); SBAR(); float sacc=(P0[0]+P0[1]); \
    GAPA(C0=__builtin_amdgcn_mfma_f32_32x32x16_bf16(kf[0],qr[0],negm,0,0,0), P0[2],P0[3],P0[4],P0[5],     pw0[0]=PKW(P0,0), pw0[1]=PKW(P0,2), pw0); \
    VRD(4); SBAR(); GAPA(C1=__builtin_amdgcn_mfma_f32_32x32x16_bf16(kf[1],qr[0],negm,0,0,0), P0[6],P0[7],P0[8],P0[9],     pw0[2]=PKW(P0,4), pw0[3]=PKW(P0,6), pw0); \
    VRD(1); SBAR(); GAPA(C0=__builtin_amdgcn_mfma_f32_32x32x16_bf16(kf[2],qr[1],C0,0,0,0),   P0[10],P0[11],P0[12],P0[13], pw1[0]=PKW(P0,8), pw1[1]=PKW(P0,10), pw1); \
    VRD(5); SBAR(); GAPA(C1=__builtin_amdgcn_mfma_f32_32x32x16_bf16(kf[3],qr[1],C1,0,0,0),   P0[14],P0[15],P1[0],P1[1],   pw1[2]=PKW(P0,12),pw1[3]=PKW(P0,14), pw1); \
    VRD(2); SBAR(); GAPA(C0=__builtin_amdgcn_mfma_f32_32x32x16_bf16(kf[4],qr[2],C0,0,0,0),   P1[2],P1[3],P1[4],P1[5],     pw2[0]=PKW(P1,0), pw2[1]=PKW(P1,2), pw2); \
    VRD(6); SBAR(); GAPA(C1=__builtin_amdgcn_mfma_f32_32x32x16_bf16(kf[5],qr[2],C1,0,0,0),   P1[6],P1[7],P1[8],P1[9],     pw2[2]=PKW(P1,4), pw2[3]=PKW(P1,6), pw2); \
    VRD(3); SBAR(); GAPA(C0=__builtin_amdgcn_mfma_f32_32x32x16_bf16(kf[6],qr[3],C0,0,0,0),   P1[10],P1[11],P1[12],P1[13], pw3[0]=PKW(P1,8), pw3[1]=PKW(P1,10), pw3); \
    VRD(7); SBAR(); GAPA(C1=__builtin_amdgcn_mfma_f32_32x32x16_bf16(kf[7],qr[3],C1,0,0,0),   P1[14],P1[15],0.f,0.f,       pw3[2]=PKW(P1,12),pw3[3]=PKW(P1,14), pw3); \
    KAUG(ka0,2*(t)); KAUG(ka1,2*(t)+1); \
    C0=__builtin_amdgcn_mfma_f32_32x32x16_bf16(ka0,qaug,C0,0,0,0); C1=__builtin_amdgcn_mfma_f32_32x32x16_bf16(ka1,qaug,C1,0,0,0); SBAR(); \
    l_reg+=sacc; \
    if(GK){DMA_K((t)+3,sl_cur);} if(GV){DMA_V((t)+1,sl_next);} \
    CMASK(C0,C1,t); \
    { float a=MX3(C0[0],C0[1],C1[0]),b=MX3(C0[2],C0[3],C1[1]); a=MX3(a,C1[2],C1[3]); \
      _Pragma("unroll") for(int r=4;r<16;r+=4){a=MX3(a,C0[r],C0[r+1]);b=MX3(b,C0[r+2],C0[r+3]);a=MX3(a,C1[r],C1[r+1]);b=MX3(b,C1[r+2],C1[r+3]);} \
      float rm=__builtin_fmaxf(a,b); { auto rr=__builtin_amdgcn_permlane32_swap(__float_as_uint(rm),__float_as_uint(rm),false,false); rm=__builtin_fmaxf(__uint_as_float(rr[0]),__uint_as_float(rr[1])); } \
      resc=false; \
      if(__builtin_expect(__any(rm>(float)THRL),0)){ const float dl=__builtin_fmaxf(rm,0.f); mhat+=dl; \
        _Pragma("unroll") for(int r=0;r<16;++r){C0[r]-=dl;C1[r]-=dl;} \
        _Pragma("unroll") for(int r=0;r<16;++r)negm[r]=-mhat; asm volatile("":"+v"(negm)); \
        const float f=__builtin_amdgcn_exp2f(-dl); l_reg*=f; if(hi==0)wsf[r32]=f; resc=true; } } \
    SBAR(); \
    GAPB(o[0]=__builtin_amdgcn_mfma_f32_32x32x16_bf16(PAF(0),VFR(0),o[0],0,0,0), C0,0); \
    GAPB(o[1]=__builtin_amdgcn_mfma_f32_32x32x16_bf16(PAF(0),VFR(4),o[1],0,0,0), C0,4); \
    KRD(GL,0); GAPB(o[0]=__builtin_amdgcn_mfma_f32_32x32x16_bf16(PAF(1),VFR(1),o[0],0,0,0), C0,8); \
    KRD(GL,1); GAPB(o[1]=__builtin_amdgcn_mfma_f32_32x32x16_bf16(PAF(1),VFR(5),o[1],0,0,0), C0,12); \
    KRD(GL,2); GAPB(o[0]=__builtin_amdgcn_mfma_f32_32x32x16_bf16(PAF(2),VFR(2),o[0],0,0,0), C1,0); \
    KRD(GL,3); GAPB(o[1]=__builtin_amdgcn_mfma_f32_32x32x16_bf16(PAF(2),VFR(6),o[1],0,0,0), C1,4); \
    GAPB(o[0]=__builtin_amdgcn_mfma_f32_32x32x16_bf16(PAF(3),VFR(3),o[0],0,0,0), C1,8); \
    GAPB(o[1]=__builtin_amdgcn_mfma_f32_32x32x16_bf16(PAF(3),VFR(7),o[1],0,0,0), C1,12); \
    }while(0)
  int t=1;
  #undef CMASK
  #define CMASK(P0,P1,t) do{}while(0)
  for(;t+5<NT;t+=2){
    STEP(pB0,pB1,pA0,pA1,t,true,true,true);     WAIT_BAR(2); RESC(); ROT();
    STEP(pA0,pA1,pB0,pB1,t+1,true,true,true);   WAIT_BAR(2); RESC(); ROT();
  }
  #undef CMASK
  #define CMASK(P0,P1,t) do{int jb_=(t)-(NT-4); if(jb_>=0)cmask(P0,P1,jb_,qrel,hi);}while(0)
  #define ENDW(tt) do{ if((tt)+3<NT){WAIT_BAR(2);} else if((tt)+2<NT){WAIT_BAR(1);} else {WAIT_BAR(0);} }while(0)
  for(;t+1<NT;t+=2){
    STEP(pB0,pB1,pA0,pA1,t,(t+3<NT),(t+1<NT),(t+1<NT));       ENDW(t);   RESC(); ROT();
    STEP(pA0,pA1,pB0,pB1,t+1,(t+4<NT),(t+2<NT),(t+2<NT));     ENDW(t+1); RESC(); ROT();
  }
  STEP(pB0,pB1,pA0,pA1,NT-1,false,false,false); RESC();
  { float sacc=pB0[0]+pB0[1]; _Pragma("unroll") for(int r=2;r<16;++r)sacc+=pB0[r]; _Pragma("unroll") for(int r=0;r<16;++r)sacc+=pB1[r]; l_reg+=sacc;
    pw0=(u32x4){PKW(pB0,0),PKW(pB0,2),PKW(pB0,4),PKW(pB0,6)};pw1=(u32x4){PKW(pB0,8),PKW(pB0,10),PKW(pB0,12),PKW(pB0,14)};pw2=(u32x4){PKW(pB1,0),PKW(pB1,2),PKW(pB1,4),PKW(pB1,6)};pw3=(u32x4){PKW(pB1,8),PKW(pB1,10),PKW(pB1,12),PKW(pB1,14)};
    SBAR(); pv(o,vb0+sl_cur,PAF(0),PAF(1),PAF(2),PAF(3)); }
  #undef PKW
  #undef PAF
  #undef VFR
  #undef PIN
  #undef MX3
  #undef GAPA
  #undef GAPB
  #undef EX
  #undef VRD
  #undef KRD
  #undef STEP
  #undef ENDW
  {auto rr=__builtin_amdgcn_permlane32_swap(__float_as_uint(l_reg),__float_as_uint(l_reg),false,false);l_reg=__uint_as_float(rr[0])+__uint_as_float(rr[1]);}
  if(hi==0)wsf[32+r32]=l_reg;asm volatile("s_waitcnt lgkmcnt(0)":::"memory");
  float rli[16];
  #pragma unroll
  for(int r=0;r<16;++r)rli[r]=__builtin_amdgcn_rcpf(wsf[32+crow(r,hi)]);
  bf16*Ow=O+(rowbase+q0+wid*QBLK)*OPITCH+hm*128+vh*D;
  { bf16*stg=(bf16*)(shm+LDS_OST)+wid*2048;
    #pragma unroll
    for(int r=0;r<16;++r){const int orow=crow(r,hi);
      #pragma unroll
      for(int d0=0;d0<2;++d0)stg[orow*64+d0*32+r32]=__float2bfloat16(o[d0][r]*rli[r]);}
    asm volatile("s_waitcnt lgkmcnt(0)":::"memory");
    #pragma unroll
    for(int i=0;i<4;++i){const int row=i*8+(lane>>3),ch=lane&7; const u32x4 v=*(const u32x4*)(stg+row*64+ch*8); ATTN_STORE16(Ow+(long)row*OPITCH+ch*8,v);} }
  asm volatile("s_waitcnt lgkmcnt(0)\n\ts_barrier":::"memory");
  #undef DMA_K
  #undef DMA_V
  #undef KAUG
  #undef CMASK
  #undef START
  #undef RESC
  #undef ROT
}
constexpr int ATTN_LDS_BYTES=LDS_BYTES;
struct AttnTensors { const bf16* Q; const bf16* K; const bf16* V; bf16* O; };
struct AttnUnit { int item; int qb; };
struct StaticOrder {
  int vcu, G;
  __device__ __forceinline__ explicit StaticOrder(int grid,int block):vcu((grid%8==0)?(block%8)*(grid/8)+block/8:block),G(grid){}
  __device__ __forceinline__ bool next(int i,AttnUnit&u)const{ const int L=vcu+(i>>3)*G; if(L>=BATCH*NHEAD*2)return false; u.item=L; u.qb=7-(i&7); return true; }
  __device__ __forceinline__ void a_ready(const AttnUnit&)const{}
  __device__ __forceinline__ void done(const AttnUnit&)const{}
};
template<class Sched,int THRL=8> __device__ __forceinline__ void attn_phase(char*lds,const AttnTensors&T,const Sched&S){
  AttnUnit u;
  for(int i=0;S.next(i,u);++i){ S.a_ready(u); attn_unit<THRL>(u.item>>5,(u.item>>1)&15,u.item&1,u.qb,T.Q,T.K,T.V,T.O,lds); S.done(u); }
}
#undef SBAR
#undef WAIT_BAR
}
#define GAS __attribute__((address_space(1)))
#define LAS __attribute__((address_space(3)))
typedef unsigned short bf16;
typedef unsigned v4u __attribute__((ext_vector_type(4)));
typedef float f32x4 __attribute__((ext_vector_type(4)));
typedef short bf16x8 __attribute__((ext_vector_type(8)));
typedef GAS unsigned gu32;
typedef GAS unsigned long long gu64;
#define RLX_AGENT __ATOMIC_RELAXED, __HIP_MEMORY_SCOPE_AGENT
#define LDS_WAIT() asm volatile("s_waitcnt lgkmcnt(0)" ::: "memory")
#define VM_WAIT() asm volatile("s_waitcnt vmcnt(0)" ::: "memory")
__device__ __forceinline__ unsigned long long rt() { return __builtin_amdgcn_s_memrealtime(); }
__device__ __forceinline__ unsigned f2bf(float f) { unsigned u = __builtin_bit_cast(unsigned, f); return (u + 0x7fffu + ((u >> 16) & 1u)) >> 16; }
__device__ __forceinline__ unsigned pk2(float lo, float hi) { return f2bf(lo) | (f2bf(hi) << 16); }

#define XB_TMO      128
#define XB_XCNT(j)  (256  + 64 * (j))
#define XB_XSUB(j)  (1280 + 64 * (j))
#define XB_XGEN(j)  (2304 + 64 * (j))
#define XB_TOP      3328
#define XB_TOPGEN   3392
#define XCD_BAR_WORDS 3456
#define XB_SPIN_CAP (1u << 18)

__device__ __forceinline__ unsigned xb_ld(unsigned* p)              { return __hip_atomic_load(p, __ATOMIC_RELAXED, __HIP_MEMORY_SCOPE_AGENT); }
__device__ __forceinline__ unsigned xb_add(unsigned* p, unsigned v) { return __hip_atomic_fetch_add(p, v, __ATOMIC_RELAXED, __HIP_MEMORY_SCOPE_AGENT); }
__device__ __forceinline__ unsigned xb_xcc_id() { return (unsigned)__builtin_amdgcn_s_getreg((3 << 11) | 20) & 0xFu; }
#define XB_SPIN(cond, bar) do { unsigned _sp = 0; while (cond) { __builtin_amdgcn_s_sleep(1); \
    if ((++_sp & 255u) == 0u) { if (xb_ld(&(bar)[XB_TMO])) break; if (_sp > XB_SPIN_CAP) { atomicAdd(&(bar)[XB_TMO], 1u); break; } } } } while (0)

struct XcdBarrier {
    unsigned* bar; unsigned x;
    volatile LAS unsigned* st;
};

__device__ __forceinline__ XcdBarrier xcd_barrier_post(unsigned* bar, volatile LAS unsigned* st) {
    XcdBarrier b; b.bar = bar; b.x = xb_xcc_id(); b.st = st;
    if (threadIdx.x == 0) (void)xb_add(&bar[XB_XCNT(b.x)], 1u);
    return b;
}
__device__ __forceinline__ void xcd_barrier_complete(unsigned* bar, unsigned x, unsigned& nloc, unsigned& nx) {
    const unsigned G = gridDim.x * gridDim.y * gridDim.z;
    unsigned sum, cnt, mine, sp = 0u;
    for (;;) {
        sum = 0u; cnt = 0u; mine = 0u;
#pragma unroll
        for (unsigned j = 0; j < 16; ++j) { const unsigned c = xb_ld(&bar[XB_XCNT(j)]); sum += c; cnt += (c > 0u) ? 1u : 0u; mine = (j == x) ? c : mine; }
        if (sum == G) break;
        __builtin_amdgcn_s_sleep(1);
        if ((++sp & 255u) == 0u) { if (xb_ld(&bar[XB_TMO])) break; if (sp > XB_SPIN_CAP) { atomicAdd(&bar[XB_TMO], 1u); break; } }
    }
    nloc = mine > 0u ? mine : 1u; nx = cnt > 0u ? cnt : 1u;
}

__device__ __forceinline__ void xcd_barrier(const XcdBarrier& b) {
    asm volatile("s_waitcnt vmcnt(0)" ::: "memory");
    __syncthreads();
    if (threadIdx.x == 0) {
        unsigned* bar = b.bar;
        __builtin_amdgcn_s_waitcnt(0);
        unsigned nloc = b.st[0], nx = b.st[1];
        if (nloc == 0u) { xcd_barrier_complete(bar, b.x, nloc, nx); b.st[0] = nloc; b.st[1] = nx; }
        const unsigned old = xb_add(&bar[XB_XSUB(b.x)], 1u);
        const unsigned gen = old / nloc;
        if (old + 1u == (gen + 1u) * nloc) {
            __builtin_amdgcn_fence(__ATOMIC_RELEASE, "agent");
            asm volatile("s_waitcnt vmcnt(0)" ::: "memory");
            const unsigned og = xb_add(&bar[XB_TOP], 1u);
            const unsigned tg = og / nx;
            if (og + 1u == (tg + 1u) * nx) xb_add(&bar[XB_TOPGEN], 1u);
            else XB_SPIN(xb_ld(&bar[XB_TOPGEN]) == tg, bar);
            __builtin_amdgcn_fence(__ATOMIC_ACQUIRE, "agent");
            xb_add(&bar[XB_XGEN(b.x)], 1u);
            asm volatile("s_waitcnt vmcnt(0)" ::: "memory");
        } else {
            XB_SPIN(xb_ld(&bar[XB_XGEN(b.x)]) == gen, bar);
            __builtin_amdgcn_fence(__ATOMIC_ACQUIRE, "agent");
            asm volatile("s_waitcnt vmcnt(0)" ::: "memory");
        }
    }
    __syncthreads();
}

constexpr int NWAVES = 8, NTHR = NWAVES * 64;
constexpr int BATCH = 8, SEQ = 2048, D = 1024, M = BATCH * SEQ, FF = 2816, NIN = 10272;
constexpr int SSD_INNER = 2048, SSD_H = 32, SSD_P = 64, SSD_N = 128, CONV_CH = 3072;
constexpr int DA_H = 8;
constexpr float EPS = 1e-6f, LOG2E = 1.4426950408889634f;
constexpr float QSCALE = 0.125f * LOG2E;
constexpr float LAM_INIT = 0.2f;
constexpr int NPH = 18;
#ifndef SSD_SIMPLE
#define SSD_SIMPLE 0
#endif
constexpr int SSQ_PITCH = SSD_SIMPLE ? 32 : 64, SSQ_PER_GROUP = SSD_SIMPLE ? 8 : 16;
enum { I_X = 0, I_F1_PRE, I_F1_WG, I_F1_WU, I_F1_WD, I_F1_POST, I_MIX_PRE, I_WIN, I_GATE_B, I_CONV_W, I_CONV_B, I_DT_BIAS, I_A_LOG, I_SSD_D, I_SSD_NORM, I_SSD_W,
       I_LQ1, I_LK1, I_LQ2, I_LK2, I_SUBLN, I_DA_W, I_WOUT, I_MIX_POST, I_F2_PRE, I_F2_WG, I_F2_WU, I_F2_WD, I_F2_POST, N_INPUTS };

constexpr size_t MiB = 1u << 20;
constexpr size_t WS_CTL = 0, CTL_ZERO_BYTES = 1 * MiB;
constexpr size_t WS_WGU = 1 * MiB, WS_WD = 12 * MiB, WS_WQKV = 18 * MiB, WS_WZX = 24 * MiB, WS_WGATE = 34 * MiB, WS_WSSD = 38 * MiB, WS_WDA = 42 * MiB, WS_WOUT = 44 * MiB, WS_WDT = 46 * MiB;
constexpr size_t WS_F1N = 48 * MiB, WS_XN = 80 * MiB;
constexpr size_t WS_H = 112 * MiB;
constexpr size_t WS_Q = 112 * MiB, WS_K = 144 * MiB, WS_V = 176 * MiB;
constexpr size_t WS_AN = 112 * MiB;
constexpr size_t WS_XBC = 144 * MiB;
constexpr size_t WS_DT = 240 * MiB, WS_SSQP = 242 * MiB;
constexpr size_t WS_GATES = 144 * MiB, WS_MERGED = 208 * MiB;
constexpr size_t WS_TMP = 48 * MiB;
constexpr size_t WS_END = 256 * MiB;
constexpr int CW_TMO = 0, CW_CODE = 1, CW_BAR = 4096;

constexpr int RING_OFF = 0, RING_BYTES = 131072;
constexpr int LDSCTL_OFF = 155648, MISC_OFF = LDSCTL_OFF + 320;
constexpr int LDS_BYTES = 159744;

struct Args { const float* in[N_INPUTS]; float* out; unsigned char* ws; int ph_lo, ph_hi; int pad0, pad1; };
static_assert(sizeof(Args) == N_INPUTS * 8 + 8 + 8 + 16, "Args has no padding holes");

typedef const __attribute__((address_space(4))) Args* ArgsP;
__device__ __forceinline__ ArgsP kargs() { ArgsP p = (ArgsP)__builtin_amdgcn_kernarg_segment_ptr(); asm volatile("" : "+s"(p)); return p; }
struct Ctx { LAS unsigned char* lds; int tid, lane, wave, vcu, G; };
__device__ __forceinline__ bool fresh(Ctx& c) { int t = threadIdx.x; asm volatile("" : "+v"(t)); c.tid = t; c.lane = t & 63; return true; }

__device__ __forceinline__ float wave_sum(float v) {
#pragma unroll
    for (int o = 1; o < 64; o <<= 1) v += __shfl_xor(v, o);
    return v;
}
__device__ __forceinline__ float bflo(unsigned w) { return __uint_as_float(w << 16); }
__device__ __forceinline__ float bfhi(unsigned w) { return __uint_as_float(w & 0xffff0000u); }
__device__ __forceinline__ float bf1(bf16 h) { return __uint_as_float((unsigned)h << 16); }
__device__ __forceinline__ float sigm(float x) { return 1.0f / (1.0f + __expf(-x)); }

__device__ __forceinline__ void transpose_item(const float* W, int ldw, int K, bf16* WT, int dst_row0, int k0, int n0, LAS float* scr, int lane) {
#pragma unroll 8
    for (int i = 0; i < 32; ++i) { const int kk = 2 * i + (lane >> 5); scr[kk * 33 + (lane & 31)] = W[(size_t)(k0 + kk) * ldw + n0 + (lane & 31)]; }
    LDS_WAIT(); asm volatile("" ::: "memory");
    const int c = lane & 7;
#pragma unroll
    for (int j = 0; j < 4; ++j) { const int n = (lane >> 3) + 8 * j; const LAS float* s = scr + (8 * c) * 33 + n;
        v4u o; o.x = pk2(s[0 * 33], s[1 * 33]); o.y = pk2(s[2 * 33], s[3 * 33]); o.z = pk2(s[4 * 33], s[5 * 33]); o.w = pk2(s[6 * 33], s[7 * 33]);
        *(GAS v4u*)(WT + (size_t)(dst_row0 + n) * K + k0 + 8 * c) = o; }
    LDS_WAIT(); asm volatile("" ::: "memory");
}
constexpr int FFN_ITEMS = 3 * 16 * 88;
__device__ __forceinline__ void ffn_weight_item(const float* wg, const float* wu, const float* wd, unsigned char* ws, int it, LAS float* scr, int lane) {
    bf16* WGU = (bf16*)(ws + WS_WGU); bf16* WD = (bf16*)(ws + WS_WD);
    if (it < 2 * 1408) { const bool up = it >= 1408; const int r = up ? it - 1408 : it; const int kb = r / 88, nb = r % 88, n0 = nb * 32;
        transpose_item(up ? wu : wg, FF, D, WGU, 256 * (n0 >> 7) + (up ? 128 : 0) + (n0 & 127), kb * 64, n0, scr, lane); }
    else { const int r = it - 2 * 1408; const int kb = r / 32, nb = r % 32;
        transpose_item(wd, D, FF, WD, nb * 32, kb * 64, nb * 32, scr, lane); }
}
constexpr int WIN_ITEMS = 16 * 321, WSSD_ITEMS = 32 * 32, WSQ_ITEMS = 16 * 32;
__device__ __forceinline__ void mixer_weight_item(ArgsP a, int it, LAS float* scr, int lane) {
    unsigned char* ws = a->ws;
    if (it < WIN_ITEMS) { const int kb = it / 321, nb = it % 321, n0 = nb * 32; bf16* dst; int row;
        if (n0 < 5120) { dst = (bf16*)(ws + WS_WZX); row = n0; }
        else if (n0 < 5152) { dst = (bf16*)(ws + WS_WDT); row = n0 - 5120; }
        else if (n0 < 8224) { dst = (bf16*)(ws + WS_WQKV); row = n0 - 5152; }
        else { dst = (bf16*)(ws + WS_WGATE); row = n0 - 8224; }
        transpose_item(a->in[I_WIN], NIN, D, dst, row, kb * 64, n0, scr, lane); return; }
    it -= WIN_ITEMS;
    if (it < WSSD_ITEMS) { const int kb = it / 32, nb = it % 32; transpose_item(a->in[I_SSD_W], D, SSD_INNER, (bf16*)(ws + WS_WSSD), nb * 32, kb * 64, nb * 32, scr, lane); return; }
    it -= WSSD_ITEMS;
    if (it < WSQ_ITEMS) { const int kb = it / 32, nb = it % 32; transpose_item(a->in[I_DA_W], D, D, (bf16*)(ws + WS_WDA), nb * 32, kb * 64, nb * 32, scr, lane); return; }
    it -= WSQ_ITEMS;
    { const int kb = it / 32, nb = it % 32; transpose_item(a->in[I_WOUT], D, D, (bf16*)(ws + WS_WOUT), nb * 32, kb * 64, nb * 32, scr, lane); }
}
constexpr int MIXER_ITEMS = WIN_ITEMS + WSSD_ITEMS + 2 * WSQ_ITEMS;

__device__ __forceinline__ void row_load(const float* row, int lane, f32x4 (&v)[4]) {
    const GAS f32x4* p = (const GAS f32x4*)row + lane;
#pragma unroll
    for (int j = 0; j < 4; ++j) v[j] = p[64 * j];
}
__device__ __forceinline__ void row_store(float* row, int lane, const f32x4 (&v)[4]) {
    GAS f32x4* p = (GAS f32x4*)row + lane;
#pragma unroll
    for (int j = 0; j < 4; ++j) p[64 * j] = v[j];
}
__device__ __forceinline__ void row_load_bf(const bf16* row, int lane, f32x4 (&v)[4]) {
    const GAS unsigned long long* p = (const GAS unsigned long long*)row + lane;
#pragma unroll
    for (int j = 0; j < 4; ++j) { const unsigned long long w = p[64 * j]; const unsigned lo = (unsigned)w, hi = (unsigned)(w >> 32); v[j] = (f32x4){bflo(lo), bfhi(lo), bflo(hi), bfhi(hi)}; }
}
__device__ __forceinline__ void row_store_bf_round(bf16* row, int lane, f32x4 (&v)[4]) {
    GAS unsigned long long* p = (GAS unsigned long long*)row + lane;
#pragma unroll
    for (int j = 0; j < 4; ++j) { const unsigned lo = pk2(v[j].x, v[j].y), hi = pk2(v[j].z, v[j].w); p[64 * j] = (unsigned long long)lo | ((unsigned long long)hi << 32);
        v[j] = (f32x4){bflo(lo), bfhi(lo), bflo(hi), bfhi(hi)}; }
}
__device__ __forceinline__ float row_rstd(const f32x4 (&v)[4]) {
    float s = 0.f;
#pragma unroll
    for (int j = 0; j < 4; ++j) s += (v[j].x * v[j].x + v[j].y * v[j].y) + (v[j].z * v[j].z + v[j].w * v[j].w);
    return 1.0f / sqrtf(wave_sum(s) * (1.0f / D) + EPS);
}
__device__ __forceinline__ void row_scale_gain(f32x4 (&v)[4], float s, const float* g, int lane) {
    const GAS f32x4* p = (const GAS f32x4*)g + lane;
#pragma unroll
    for (int j = 0; j < 4; ++j) v[j] = v[j] * s * p[64 * j];
}

__device__ __forceinline__ void ph_prologue(ArgsP a, const Ctx& c) {
    LAS float* scr = (LAS float*)(c.lds + RING_OFF + c.wave * 16384);
    const int gw = c.vcu * NWAVES + c.wave, NGW = c.G * NWAVES;
    for (int it = gw; it < FFN_ITEMS + MIXER_ITEMS; it += NGW) {
        if (it < FFN_ITEMS) ffn_weight_item(a->in[I_F1_WG], a->in[I_F1_WU], a->in[I_F1_WD], a->ws, it, scr, c.lane);
        else mixer_weight_item(a, it - FFN_ITEMS, scr, c.lane);
    }
    bf16* XN = (bf16*)(a->ws + WS_XN);
    for (int m = gw; m < M; m += NGW) { f32x4 v[4]; row_load(a->in[I_X] + (size_t)m * D, c.lane, v); const float r = row_rstd(v); row_scale_gain(v, r, a->in[I_F1_PRE], c.lane); row_store_bf_round(XN + (size_t)m * D, c.lane, v); }
}
__device__ __forceinline__ void ph_e2(ArgsP a, const Ctx& c) {
    const int gw = c.vcu * NWAVES + c.wave, NGW = c.G * NWAVES; bf16* XN = (bf16*)(a->ws + WS_XN); bf16* F1N = (bf16*)(a->ws + WS_F1N);
    for (int m = gw; m < M; m += NGW) { f32x4 v[4], x[4]; row_load(a->out + (size_t)m * D, c.lane, v); row_load(a->in[I_X] + (size_t)m * D, c.lane, x);
        const float r = row_rstd(v); row_scale_gain(v, 0.5f * r, a->in[I_F1_POST], c.lane); row_store_bf_round(F1N + (size_t)m * D, c.lane, v);
#pragma unroll
        for (int j = 0; j < 4; ++j) v[j] = v[j] + x[j];
        const float r2 = row_rstd(v); row_scale_gain(v, r2, a->in[I_MIX_PRE], c.lane); row_store_bf_round(XN + (size_t)m * D, c.lane, v); }
}
__device__ __forceinline__ void ph_e8(ArgsP a, const Ctx& c) {
    const int gw = c.vcu * NWAVES + c.wave, NGW = c.G * NWAVES; bf16* XN = (bf16*)(a->ws + WS_XN); const bf16* F1N = (const bf16*)(a->ws + WS_F1N);
    for (int m = gw; m < M; m += NGW) { f32x4 v[4], x[4], f[4]; row_load(a->out + (size_t)m * D, c.lane, v); row_load(a->in[I_X] + (size_t)m * D, c.lane, x); row_load_bf(F1N + (size_t)m * D, c.lane, f);
        const float r = row_rstd(v); row_scale_gain(v, r, a->in[I_MIX_POST], c.lane);
#pragma unroll
        for (int j = 0; j < 4; ++j) v[j] = v[j] + x[j] + f[j];
        row_store(a->out + (size_t)m * D, c.lane, v);
        const float r2 = row_rstd(v); row_scale_gain(v, r2, a->in[I_F2_PRE], c.lane); row_store_bf_round(XN + (size_t)m * D, c.lane, v); }
}
__device__ __forceinline__ void ph_e10(ArgsP a, const Ctx& c) {
    const int gw = c.vcu * NWAVES + c.wave, NGW = c.G * NWAVES; const float* TMP = (const float*)(a->ws + WS_TMP);
    for (int m = gw; m < M; m += NGW) { f32x4 v[4], h[4]; row_load(TMP + (size_t)m * D, c.lane, v); row_load(a->out + (size_t)m * D, c.lane, h);
        const float r = row_rstd(v); row_scale_gain(v, 0.5f * r, a->in[I_F2_POST], c.lane);
#pragma unroll
        for (int j = 0; j < 4; ++j) v[j] = v[j] + h[j];
        row_store(a->out + (size_t)m * D, c.lane, v); }
}
__device__ __forceinline__ void ph_attn_simple(ArgsP a, const Ctx& c) {
    const bf16* Q = (const bf16*)(a->ws + WS_Q); const bf16* K = (const bf16*)(a->ws + WS_K); const bf16* V = (const bf16*)(a->ws + WS_V); bf16* O = (bf16*)a->out;
    for (int item = c.vcu; item < BATCH * 32; item += c.G) {
        const int b = item >> 5, hm = (item >> 1) & 15, vh = item & 1, h = hm >> 1;
        const float sl2 = exp2f(-(float)(h + 1)) * LOG2E;
        for (int r = 0; r < 4; ++r) {
            const int qpos = c.tid + NTHR * r; const size_t qrow = (size_t)(b * SEQ + qpos);
            float q[64], o[64];
            { const GAS v4u* qp = (const GAS v4u*)(Q + qrow * 1024 + hm * 64);
#pragma unroll
              for (int i = 0; i < 8; ++i) { const v4u w = qp[i]; q[8 * i] = bflo(w.x); q[8 * i + 1] = bfhi(w.x); q[8 * i + 2] = bflo(w.y); q[8 * i + 3] = bfhi(w.y); q[8 * i + 4] = bflo(w.z); q[8 * i + 5] = bfhi(w.z); q[8 * i + 6] = bflo(w.w); q[8 * i + 7] = bfhi(w.w); } }
#pragma unroll
            for (int d = 0; d < 64; ++d) o[d] = 0.f;
            float mrun = -1e30f, l = 0.f;
            const int jmax = qpos | 63;
            for (int j = 0; j <= jmax; ++j) {
                const GAS v4u* kp = (const GAS v4u*)(K + (size_t)(b * SEQ + j) * 1024 + hm * 64);
                const GAS v4u* vp = (const GAS v4u*)(V + (size_t)(b * SEQ + j) * 1024 + h * 128 + vh * 64);
                float s = 0.f;
#pragma unroll
                for (int i = 0; i < 8; ++i) { const v4u w = kp[i]; s += q[8 * i] * bflo(w.x) + q[8 * i + 1] * bfhi(w.x) + q[8 * i + 2] * bflo(w.y) + q[8 * i + 3] * bfhi(w.y) + q[8 * i + 4] * bflo(w.z) + q[8 * i + 5] * bfhi(w.z) + q[8 * i + 6] * bflo(w.w) + q[8 * i + 7] * bfhi(w.w); }
                s += sl2 * (float)(j - qpos);
                if (j <= qpos) {
                    const float mn = fmaxf(mrun, s), al = exp2f(mrun - mn), p = exp2f(s - mn); l = l * al + p; mrun = mn;
#pragma unroll
                    for (int i = 0; i < 8; ++i) { const v4u w = vp[i];
                        o[8 * i] = o[8 * i] * al + p * bflo(w.x); o[8 * i + 1] = o[8 * i + 1] * al + p * bfhi(w.x); o[8 * i + 2] = o[8 * i + 2] * al + p * bflo(w.y); o[8 * i + 3] = o[8 * i + 3] * al + p * bfhi(w.y);
                        o[8 * i + 4] = o[8 * i + 4] * al + p * bflo(w.z); o[8 * i + 5] = o[8 * i + 5] * al + p * bfhi(w.z); o[8 * i + 6] = o[8 * i + 6] * al + p * bflo(w.w); o[8 * i + 7] = o[8 * i + 7] * al + p * bfhi(w.w); }
                }
            }
            const float rl = 1.0f / l; GAS v4u* op = (GAS v4u*)(O + qrow * 2048 + hm * 128 + vh * 64);
#pragma unroll
            for (int i = 0; i < 8; ++i) { v4u w; w.x = pk2(o[8 * i] * rl, o[8 * i + 1] * rl); w.y = pk2(o[8 * i + 2] * rl, o[8 * i + 3] * rl); w.z = pk2(o[8 * i + 4] * rl, o[8 * i + 5] * rl); w.w = pk2(o[8 * i + 6] * rl, o[8 * i + 7] * rl); op[i] = w; }
        }
    }
}
__device__ __forceinline__ void ph_attn_final(ArgsP a, const Ctx& c) {
    const int gw = c.vcu * NWAVES + c.wave, NGW = c.G * NWAVES;
    { LAS float* scr = (LAS float*)(c.lds + RING_OFF + c.wave * 16384);
      for (int it = gw; it < FFN_ITEMS; it += NGW) ffn_weight_item(a->in[I_F2_WG], a->in[I_F2_WU], a->in[I_F2_WD], a->ws, it, scr, c.lane); }
    const float s1 = wave_sum(a->in[I_LQ1][c.lane] * a->in[I_LK1][c.lane]), s2 = wave_sum(a->in[I_LQ2][c.lane] * a->in[I_LK2][c.lane]);
    const float lam = __expf(s1) - __expf(s2) + LAM_INIT;
    const float g0 = a->in[I_SUBLN][2 * c.lane] * (1.0f - LAM_INIT), g1 = a->in[I_SUBLN][2 * c.lane + 1] * (1.0f - LAM_INIT);
    const bf16* O = (const bf16*)a->out; bf16* AN = (bf16*)(a->ws + WS_AN);
    for (int m = gw; m < M; m += NGW) {
        const GAS unsigned* op = (const GAS unsigned*)(O + (size_t)m * 2048) + c.lane; GAS unsigned* ap = (GAS unsigned*)(AN + (size_t)m * 1024) + c.lane;
#pragma unroll
        for (int h = 0; h < DA_H; ++h) { const unsigned w0 = op[h * 128], w1 = op[h * 128 + 64];
            const float x0 = bflo(w0) - lam * bflo(w1), x1 = bfhi(w0) - lam * bfhi(w1);
            const float r = 1.0f / sqrtf(wave_sum(x0 * x0 + x1 * x1) * (1.0f / 128.0f) + EPS);
            ap[h * 64] = pk2(x0 * r * g0, x1 * r * g1); }
    }
}
__device__ __forceinline__ void ph_dt(ArgsP a, const Ctx& c) {
    const bf16* XN = (const bf16*)(a->ws + WS_XN); const bf16* WDT = (const bf16*)(a->ws + WS_WDT); float* DT = (float*)(a->ws + WS_DT);
    for (int idx = c.vcu * NTHR + c.tid; idx < M * SSD_H; idx += c.G * NTHR) {
        const int t = idx >> 5, h = idx & 31; const GAS v4u* xp = (const GAS v4u*)(XN + (size_t)t * D); const GAS v4u* wp = (const GAS v4u*)(WDT + (size_t)h * D);
        float s = 0.f;
        for (int i = 0; i < D / 8; ++i) { const v4u x = xp[i], w = wp[i];
            s += bflo(x.x) * bflo(w.x) + bfhi(x.x) * bfhi(w.x) + bflo(x.y) * bflo(w.y) + bfhi(x.y) * bfhi(w.y) + bflo(x.z) * bflo(w.z) + bfhi(x.z) * bfhi(w.z) + bflo(x.w) * bflo(w.w) + bfhi(x.w) * bfhi(w.w); }
        s += a->in[I_DT_BIAS][h];
        DT[idx] = s > 20.f ? s : log1pf(__expf(s));
    }
}
__device__ __forceinline__ void ph_ssd_simple(ArgsP a, const Ctx& c) {
    bf16* Z = (bf16*)a->out; const bf16* XBC = (const bf16*)(a->ws + WS_XBC); const float* DT = (const float*)(a->ws + WS_DT); float* SSQP = (float*)(a->ws + WS_SSQP);
    LAS float* xL = (LAS float*)(c.lds); LAS float* BL = xL + 64 * 64; LAS float* CL = BL + 64 * 128; LAS float* yL = CL + 64 * 128; LAS float* dtL = yL + 64 * 64;
    const float* cw = a->in[I_CONV_W]; const float* cb = a->in[I_CONV_B];
    for (int item = c.vcu; item < BATCH * SSD_H; item += c.G) {
        const int b = item >> 5, h = item & 31, g = h >> 3;
        const float Ah = -__expf(a->in[I_A_LOG][h]), Dh = a->in[I_SSD_D][h];
        const int p = c.tid >> 3, nq = c.tid & 7;
        float st[16];
#pragma unroll
        for (int i = 0; i < 16; ++i) st[i] = 0.f;
        for (int sub = 0; sub < SEQ / 64; ++sub) {
            const int t0 = sub * 64;
            for (int idx = c.tid; idx < 64 * 320; idx += NTHR) {
                const int tl = idx / 320, ch = idx % 320;
                const int gc = ch < 64 ? h * 64 + ch : (ch < 192 ? 2048 + g * 128 + (ch - 64) : 2560 + g * 128 + (ch - 192));
                float acc = cb[gc];
#pragma unroll
                for (int j = 0; j < 4; ++j) { const int tt = t0 + tl - 3 + j; if (tt >= 0) acc += cw[j * CONV_CH + gc] * bf1(XBC[(size_t)(b * SEQ + tt) * CONV_CH + gc]); }
                const float v = acc * sigm(acc);
                if (ch < 64) xL[tl * 64 + ch] = v; else if (ch < 192) BL[tl * 128 + ch - 64] = v; else CL[tl * 128 + ch - 192] = v;
            }
            if (c.tid < 64) dtL[c.tid] = DT[(size_t)(b * SEQ + t0 + c.tid) * SSD_H + h];
            __syncthreads();
            for (int tl = 0; tl < 64; ++tl) {
                const float dtv = dtL[tl], dA = __expf(dtv * Ah), xv = xL[tl * 64 + p], coef = dtv * xv;
                const LAS f32x4* bp = (const LAS f32x4*)(BL + tl * 128 + nq * 16); const LAS f32x4* cp = (const LAS f32x4*)(CL + tl * 128 + nq * 16);
                float ys = 0.f;
#pragma unroll
                for (int i = 0; i < 4; ++i) { const f32x4 bv = bp[i], cv = cp[i];
#pragma unroll
                    for (int k = 0; k < 4; ++k) { st[4 * i + k] = st[4 * i + k] * dA + coef * bv[k]; ys += cv[k] * st[4 * i + k]; } }
                ys += __shfl_xor(ys, 1); ys += __shfl_xor(ys, 2); ys += __shfl_xor(ys, 4);
                if (nq == 0) yL[tl * 64 + p] = ys + Dh * xv;
            }
            __syncthreads();
#pragma unroll
            for (int i = 0; i < 8; ++i) { const int idx = c.tid + NTHR * i, tl = idx >> 6, pp = idx & 63; const size_t t = (size_t)(b * SEQ + t0 + tl);
                bf16* zp = Z + t * SSD_INNER + h * 64 + pp; const float yp = yL[tl * 64 + pp] * bf1(*zp); const bf16 yb = (bf16)f2bf(yp); *zp = yb;
                const float yr = bf1(yb); const float sq = wave_sum(yr * yr); if (c.lane == 0) SSQP[t * SSD_H + h] = sq; }
            __syncthreads();
        }
    }
}

typedef float f32x16 __attribute__((ext_vector_type(16)));
typedef unsigned u32x2 __attribute__((ext_vector_type(2)));
__device__ __forceinline__ int crow16(int r, int hi) { return (r & 3) + 8 * (r >> 2) + 4 * hi; }
__device__ __forceinline__ unsigned cvtpk(float lo, float hi) { return pg8::cvt_pk_bf16(lo, hi); }
__device__ __forceinline__ float bfsel(const v4u& w, int j) { const unsigned d = (j >> 1) == 0 ? w.x : (j >> 1) == 1 ? w.y : (j >> 1) == 2 ? w.z : w.w; return (j & 1) ? bfhi(d) : bflo(d); }
__device__ __forceinline__ float silu_fast(float x) { return x * __builtin_amdgcn_rcpf(1.0f + __builtin_amdgcn_exp2f(-LOG2E * x)); }
constexpr int SP = 272;
constexpr int SO_BS = 0, SO_CS = 34816, SO_BWT = 69632, SO_XT = 104448, SO_HT = 121856, SO_SM = 139264;
__device__ __forceinline__ void ph_ssd_mfma(ArgsP a, const Ctx& c) {
    bf16* Z = (bf16*)a->out; const bf16* XBC = (const bf16*)(a->ws + WS_XBC); const float* DT = (const float*)(a->ws + WS_DT); float* SSQP = (float*)(a->ws + WS_SSQP);
    LAS unsigned char* L = c.lds;
    LAS float* acumL = (LAS float*)(L + SO_SM); LAS float* dtL = acumL + 128; LAS float* wL = dtL + 128; LAS float* eaL = wL + 128; LAS float* cwL = eaL + 128;
    const int tid = c.tid;
    const int wv = tid >> 6; int lb = wv & 3, pb = wv >> 2, nb = wv & 3, r32 = c.lane & 31, hi = c.lane >> 5;
    for (int item = c.vcu; item < BATCH * SSD_H; item += c.G) {
        const int b = item >> 5, h = item & 31, g = h >> 3;
        const float Ah = -__expf(a->in[I_A_LOG][h]), Dh = a->in[I_SSD_D][h];
        __syncthreads();
        for (int i = tid; i < 5 * 320; i += NTHR) { const int tap = i / 320, ch = i % 320; const int gc = ch < 64 ? h * 64 + ch : (ch < 192 ? 2048 + g * 128 + (ch - 64) : 2560 + g * 128 + (ch - 192));
            cwL[i] = tap < 4 ? a->in[I_CONV_W][tap * CONV_CH + gc] : a->in[I_CONV_B][gc]; }
        f32x16 Hacc;
#pragma unroll
        for (int r = 0; r < 16; ++r) Hacc[r] = 0.f;
        for (int ck = 0; ck < SEQ / 128; ++ck) {
            const int t0 = ck * 128; const size_t trow0 = (size_t)(b * SEQ + t0);
            int lane = c.lane, w = c.wave; asm volatile("" : "+v"(lb), "+v"(pb), "+v"(nb), "+v"(r32), "+v"(hi), "+v"(lane), "+s"(w)); const int lbu = w & 3;
            float decay;
            { const float d0 = DT[(trow0 + 2 * lane) * SSD_H + h], d1 = DT[(trow0 + 2 * lane + 1) * SSD_H + h]; const float a0 = d0 * Ah, a1 = d1 * Ah; float sc = a0 + a1;
#pragma unroll
              for (int o = 1; o < 64; o <<= 1) { const float t = __shfl_up(sc, o); if (lane >= o) sc += t; }
              const float aend = __shfl(sc, 63); const float ac0 = sc - a1, ac1 = sc; decay = __expf(aend);
              if (w == 0) { acumL[2 * lane] = ac0; acumL[2 * lane + 1] = ac1; dtL[2 * lane] = d0; dtL[2 * lane + 1] = d1; wL[2 * lane] = __expf(aend - ac0) * d0; wL[2 * lane + 1] = __expf(aend - ac1) * d1;
                            eaL[2 * lane] = __expf(ac0); eaL[2 * lane + 1] = __expf(ac1); } }
#pragma unroll
            for (int rq = 0; rq < 4; ++rq) { u32x2 v; v.x = cvtpk(Hacc[4 * rq], Hacc[4 * rq + 1]); v.y = cvtpk(Hacc[4 * rq + 2], Hacc[4 * rq + 3]);
                *(LAS u32x2*)(L + SO_HT + (32 * pb + r32) * SP + (32 * nb + 8 * rq + 4 * hi) * 2) = v; }
            __syncthreads();
            for (int task = tid; task < 1280; task += NTHR) {
                const int cg = task % 40, rg = task / 40, l0 = rg * 4;
                int gcol, chl;
                if (cg < 8) { gcol = h * 64 + cg * 8; chl = cg * 8; } else if (cg < 24) { gcol = 2048 + g * 128 + (cg - 8) * 8; chl = 64 + (cg - 8) * 8; } else { gcol = 2560 + g * 128 + (cg - 24) * 8; chl = 192 + (cg - 24) * 8; }
                v4u raw[7];
#pragma unroll
                for (int i = 0; i < 7; ++i) { const int tl = t0 + l0 - 3 + i; raw[i] = (v4u){0u, 0u, 0u, 0u}; if (tl >= 0) raw[i] = *(const GAS v4u*)(XBC + (size_t)(b * SEQ + tl) * CONV_CH + gcol); }
                float wt[5][8];
#pragma unroll
                for (int tap = 0; tap < 5; ++tap) { const f32x4 q0 = *(const LAS f32x4*)(cwL + tap * 320 + chl), q1 = *(const LAS f32x4*)(cwL + tap * 320 + chl + 4);
                    wt[tap][0] = q0.x; wt[tap][1] = q0.y; wt[tap][2] = q0.z; wt[tap][3] = q0.w; wt[tap][4] = q1.x; wt[tap][5] = q1.y; wt[tap][6] = q1.z; wt[tap][7] = q1.w; }
                float v[4][8];
#pragma unroll
                for (int r = 0; r < 4; ++r)
#pragma unroll
                    for (int j = 0; j < 8; ++j) { float acc = wt[4][j];
#pragma unroll
                        for (int tap = 0; tap < 4; ++tap) acc += wt[tap][j] * bfsel(raw[r + tap], j);
                        v[r][j] = silu_fast(acc); }
                if (cg < 8) {
#pragma unroll
                    for (int j = 0; j < 8; ++j) { u32x2 o; o.x = cvtpk(v[0][j], v[1][j]); o.y = cvtpk(v[2][j], v[3][j]); *(LAS u32x2*)(L + SO_XT + (chl + j) * SP + l0 * 2) = o; }
                } else if (cg < 24) { const int n0 = (cg - 8) * 8; const f32x4 wv = *(const LAS f32x4*)(wL + l0);
#pragma unroll
                    for (int r = 0; r < 4; ++r) { v4u o; o.x = cvtpk(v[r][0], v[r][1]); o.y = cvtpk(v[r][2], v[r][3]); o.z = cvtpk(v[r][4], v[r][5]); o.w = cvtpk(v[r][6], v[r][7]); *(LAS v4u*)(L + SO_BS + (l0 + r) * SP + n0 * 2) = o; }
#pragma unroll
                    for (int j = 0; j < 8; ++j) { u32x2 o; o.x = cvtpk(v[0][j] * wv.x, v[1][j] * wv.y); o.y = cvtpk(v[2][j] * wv.z, v[3][j] * wv.w); *(LAS u32x2*)(L + SO_BWT + (n0 + j) * SP + l0 * 2) = o; }
                } else { const int n0 = (cg - 24) * 8;
#pragma unroll
                    for (int r = 0; r < 4; ++r) { v4u o; o.x = cvtpk(v[r][0], v[r][1]); o.y = cvtpk(v[r][2], v[r][3]); o.z = cvtpk(v[r][4], v[r][5]); o.w = cvtpk(v[r][6], v[r][7]); *(LAS v4u*)(L + SO_CS + (l0 + r) * SP + n0 * 2) = o; }
                }
            }
            __syncthreads();
            f32x16 g0, g1; const int sb0u = 2 * (w >> 2), sb0 = 2 * (wv >> 2);
#pragma unroll
            for (int r = 0; r < 16; ++r) { g0[r] = 0.f; g1[r] = 0.f; }
            if (sb0u <= lbu) {
#pragma unroll
                for (int ks = 0; ks < 8; ++ks) { const bf16x8 A = *(const LAS bf16x8*)(L + SO_BS + (32 * sb0 + r32) * SP + (16 * ks + 8 * hi) * 2), B = *(const LAS bf16x8*)(L + SO_CS + (32 * lb + r32) * SP + (16 * ks + 8 * hi) * 2);
                    g0 = __builtin_amdgcn_mfma_f32_32x32x16_bf16(A, B, g0, 0, 0, 0); } }
            if (sb0u + 1 <= lbu) {
#pragma unroll
                for (int ks = 0; ks < 8; ++ks) { const bf16x8 A = *(const LAS bf16x8*)(L + SO_BS + (32 * (sb0 + 1) + r32) * SP + (16 * ks + 8 * hi) * 2), B = *(const LAS bf16x8*)(L + SO_CS + (32 * lb + r32) * SP + (16 * ks + 8 * hi) * 2);
                    g1 = __builtin_amdgcn_mfma_f32_32x32x16_bf16(A, B, g1, 0, 0, 0); } }
            __syncthreads();
            { int l = 32 * lb + r32; asm volatile("" : "+v"(l));
              const float al = acumL[l];
#pragma unroll
              for (int tsel = 0; tsel < 2; ++tsel) { const int sb = sb0 + tsel; if (sb0u + tsel <= lbu) {
#pragma unroll
                  for (int rq = 0; rq < 4; ++rq) { float m[4];
#pragma unroll
                      for (int k = 0; k < 4; ++k) { const int s = 32 * sb + 8 * rq + 4 * hi + k; const float gv = tsel ? g1[4 * rq + k] : g0[4 * rq + k];
                          float val = gv * __expf(fminf(al - acumL[s], 0.f)) * dtL[s]; val = (s <= l) ? val : 0.f; if (s == l) val += Dh; m[k] = val; }
                      u32x2 o; o.x = cvtpk(m[0], m[1]); o.y = cvtpk(m[2], m[3]); *(LAS u32x2*)(L + SO_BS + l * SP + (32 * sb + 8 * rq + 4 * hi) * 2) = o; } } } }
            __syncthreads();
            { f32x16 ya, yo;
#pragma unroll
              for (int r = 0; r < 16; ++r) { ya[r] = 0.f; yo[r] = 0.f; }
              bf16 zv[16];
#pragma unroll
              for (int r = 0; r < 16; ++r) zv[r] = Z[(trow0 + 32 * lb + crow16(r, hi)) * SSD_INNER + h * 64 + 32 * pb + r32];
#pragma unroll 1
              for (int ks = 0; ks < 2 * (lbu + 1); ++ks) { const bf16x8 A = *(const LAS bf16x8*)(L + SO_BS + (32 * lb + r32) * SP + (16 * ks + 8 * hi) * 2), B = *(const LAS bf16x8*)(L + SO_XT + (32 * pb + r32) * SP + (16 * ks + 8 * hi) * 2);
                  ya = __builtin_amdgcn_mfma_f32_32x32x16_bf16(A, B, ya, 0, 0, 0); }
#pragma unroll
              for (int ks = 0; ks < 8; ++ks) { const bf16x8 A = *(const LAS bf16x8*)(L + SO_CS + (32 * lb + r32) * SP + (16 * ks + 8 * hi) * 2), B = *(const LAS bf16x8*)(L + SO_HT + (32 * pb + r32) * SP + (16 * ks + 8 * hi) * 2);
                  yo = __builtin_amdgcn_mfma_f32_32x32x16_bf16(A, B, yo, 0, 0, 0); }
#pragma unroll
              for (int r = 0; r < 16; ++r) { const int l = 32 * lb + crow16(r, hi); const float yv = (ya[r] + eaL[l] * yo[r]) * bf1(zv[r]); const bf16 yb = (bf16)(cvtpk(yv, 0.f) & 0xffffu);
                  Z[(trow0 + l) * SSD_INNER + h * 64 + 32 * pb + r32] = yb; float sq = bf1(yb) * bf1(yb);
                  sq += __shfl_xor(sq, 1); sq += __shfl_xor(sq, 2); sq += __shfl_xor(sq, 4); sq += __shfl_xor(sq, 8); sq += __shfl_xor(sq, 16);
                  if (r32 == 0) SSQP[(trow0 + l) * 64 + 2 * h + pb] = sq; }
#pragma unroll
              for (int r = 0; r < 16; ++r) Hacc[r] *= decay;
#pragma unroll
              for (int ks = 0; ks < 8; ++ks) { const bf16x8 A = *(const LAS bf16x8*)(L + SO_BWT + (32 * nb + r32) * SP + (16 * ks + 8 * hi) * 2), B = *(const LAS bf16x8*)(L + SO_XT + (32 * pb + r32) * SP + (16 * ks + 8 * hi) * 2);
                  Hacc = __builtin_amdgcn_mfma_f32_32x32x16_bf16(A, B, Hacc, 0, 0, 0); } }
            __syncthreads();
        }
    }
}
__device__ __forceinline__ void ph_ssd_final(ArgsP a, const Ctx& c) {
    const int gw = c.vcu * NWAVES + c.wave, NGW = c.G * NWAVES; bf16* Y = (bf16*)a->out; const float* SSQP = (const float*)(a->ws + WS_SSQP); const float* ng = a->in[I_SSD_NORM];
    for (int m = gw; m < M; m += NGW) {
#pragma unroll
        for (int g = 0; g < 4; ++g) { float ss = 0.f;
#pragma unroll
            for (int i = 0; i < SSQ_PER_GROUP; ++i) ss += SSQP[(size_t)m * SSQ_PITCH + g * SSQ_PER_GROUP + i];
            const float r = 1.0f / sqrtf(ss * (1.0f / 512.0f) + EPS);
            GAS v4u* yp = (GAS v4u*)(Y + (size_t)m * SSD_INNER + g * 512) + c.lane; const v4u w = *yp; const GAS f32x4* gp = (const GAS f32x4*)(ng + g * 512 + 8 * c.lane); const f32x4 g0 = gp[0], g1 = gp[1];
            v4u o; o.x = pk2(bflo(w.x) * r * g0.x, bfhi(w.x) * r * g0.y); o.y = pk2(bflo(w.y) * r * g0.z, bfhi(w.y) * r * g0.w); o.z = pk2(bflo(w.z) * r * g1.x, bfhi(w.z) * r * g1.y); o.w = pk2(bflo(w.w) * r * g1.z, bfhi(w.w) * r * g1.w);
            *yp = o; }
    }
}

#ifndef ATTN_SIMPLE
#define ATTN_SIMPLE 0
#endif
__global__ void __launch_bounds__(NTHR, 2) skel_fwd(Args args) {
    extern __shared__ __attribute__((aligned(16))) unsigned char lds[];
    Ctx c;
    c.lds = (LAS unsigned char*)lds;
    volatile LAS unsigned* MISC = (volatile LAS unsigned*)(c.lds + MISC_OFF);
    c.tid = threadIdx.x; c.lane = c.tid & 63; c.wave = __builtin_amdgcn_readfirstlane(c.tid >> 6);
    c.G = gridDim.x; { const int bx = blockIdx.x; c.vcu = (c.G % 8 == 0) ? (bx % 8) * (c.G / 8) + bx / 8 : bx; }
    unsigned char* ws = kargs()->ws; float* const outp = kargs()->out;
    gu32* ctl = (gu32*)(ws + WS_CTL);
    for (int u = c.tid; u < (LDS_BYTES - LDSCTL_OFF) / 4; u += NTHR) ((LAS unsigned*)(c.lds + LDSCTL_OFF))[u] = 0u;
    __syncthreads();
    const int lo = kargs()->ph_lo, hi = kargs()->ph_hi;
    XcdBarrier bar; bar.bar = (unsigned*)(ctl + CW_BAR); bar.x = 0; bar.st = nullptr;
    if (hi - lo > 1) bar = xcd_barrier_post((unsigned*)(ctl + CW_BAR), MISC + 8);
#define IN(k) (lo <= (k) && (k) < hi && fresh(c))
#define SEAM(k) do { if (lo <= (k) && (k) + 1 < hi) xcd_barrier(bar); } while (0)
    using namespace pg8;
    LAS unsigned char* ring = c.lds + RING_OFF;
    const bf16_t* XN = (const bf16_t*)(ws + WS_XN);

    if (IN(0)) { ph_prologue(kargs(), c); } SEAM(0);
    if (IN(1)) { Gemm g{XN, (const bf16_t*)(ws + WS_WGU), M, 2 * FF, D}; StaticOrder S; S.init(M, 2 * FF, c.G, (int)blockIdx.x); EpiSwiGLU E{(bf16_t*)(ws + WS_H), FF};
        gemm_phase<EpiSwiGLU, StaticOrder, true, true>(ring, g, S, E); } SEAM(1);
    if (IN(2)) { Gemm g{(const bf16_t*)(ws + WS_H), (const bf16_t*)(ws + WS_WD), M, D, FF}; StaticOrder S; S.init(M, D, c.G, (int)blockIdx.x); EpiF32 E{outp, D};
        gemm_phase<EpiF32, StaticOrder, true, true>(ring, g, S, E); } SEAM(2);
    if (IN(3)) { ph_e2(kargs(), c); } SEAM(3);
    if (IN(4)) { Gemm g{XN, (const bf16_t*)(ws + WS_WQKV), M, 3 * D, D}; StaticOrder S; S.init(M, 3 * D, c.G, (int)blockIdx.x);
        EpiRow8<OpQKV> E{{(bf16_t*)(ws + WS_Q), (WS_K - WS_Q) / 2, QSCALE}};
        gemm_phase<EpiRow8<OpQKV>, StaticOrder, true, true>(ring, g, S, E); } SEAM(4);
#if ATTN_SIMPLE
    if (IN(5)) { ph_attn_simple(kargs(), c); } SEAM(5);
#else
    if (IN(5)) { const attn_body::AttnTensors AT{(const attn_body::bf16*)(ws + WS_Q), (const attn_body::bf16*)(ws + WS_K), (const attn_body::bf16*)(ws + WS_V), (attn_body::bf16*)outp};
        const attn_body::StaticOrder S((int)c.G, (int)blockIdx.x);
        attn_body::attn_phase<attn_body::StaticOrder>((char*)lds + RING_OFF, AT, S); } SEAM(5);
#endif
    if (IN(6)) { ph_attn_final(kargs(), c); } SEAM(6);
    if (IN(7)) { Gemm g{XN, (const bf16_t*)(ws + WS_WZX), M, 5120, D}; StaticOrder S; S.init(M, 5120, c.G, (int)blockIdx.x);
        EpiRow8<OpZX> E{{(bf16_t*)outp, (bf16_t*)(ws + WS_XBC)}};
        gemm_phase<EpiRow8<OpZX>, StaticOrder, true, true>(ring, g, S, E);
        ph_dt(kargs(), c); } SEAM(7);
#if SSD_SIMPLE
    if (IN(8)) { ph_ssd_simple(kargs(), c); } SEAM(8);
#else
    if (IN(8)) { ph_ssd_mfma(kargs(), c); } SEAM(8);
#endif
    if (IN(9)) { ph_ssd_final(kargs(), c); } SEAM(9);
    if (IN(10)) { Gemm g{XN, (const bf16_t*)(ws + WS_WGATE), M, 2 * D, D}; StaticOrder S; S.init(M, 2 * D, c.G, (int)blockIdx.x);
        EpiRow8<OpGate> E{{(bf16_t*)(ws + WS_GATES), kargs()->in[I_GATE_B]}};
        gemm_phase<EpiRow8<OpGate>, StaticOrder, true, true>(ring, g, S, E); } SEAM(10);
    if (IN(11)) { Gemm g{(const bf16_t*)outp, (const bf16_t*)(ws + WS_WSSD), M, D, SSD_INNER}; StaticOrder S; S.init(M, D, c.G, (int)blockIdx.x);
        EpiRow8<OpMerge<true>> E{{(bf16_t*)(ws + WS_MERGED), (const bf16_t*)(ws + WS_GATES)}};
        gemm_phase<EpiRow8<OpMerge<true>>, StaticOrder, true, true>(ring, g, S, E); } SEAM(11);
    if (IN(12)) { Gemm g{(const bf16_t*)(ws + WS_AN), (const bf16_t*)(ws + WS_WDA), M, D, D}; StaticOrder S; S.init(M, D, c.G, (int)blockIdx.x);
        EpiRow8<OpMerge<false>> E{{(bf16_t*)(ws + WS_MERGED), (const bf16_t*)(ws + WS_GATES)}};
        gemm_phase<EpiRow8<OpMerge<false>>, StaticOrder, true, true>(ring, g, S, E); } SEAM(12);
    if (IN(13)) { Gemm g{(const bf16_t*)(ws + WS_MERGED), (const bf16_t*)(ws + WS_WOUT), M, D, D}; StaticOrder S; S.init(M, D, c.G, (int)blockIdx.x); EpiF32 E{outp, D};
        gemm_phase<EpiF32, StaticOrder, true, true>(ring, g, S, E); } SEAM(13);
    if (IN(14)) { ph_e8(kargs(), c); } SEAM(14);
    if (IN(15)) { Gemm g{XN, (const bf16_t*)(ws + WS_WGU), M, 2 * FF, D}; StaticOrder S; S.init(M, 2 * FF, c.G, (int)blockIdx.x); EpiSwiGLU E{(bf16_t*)(ws + WS_H), FF};
        gemm_phase<EpiSwiGLU, StaticOrder, true, true>(ring, g, S, E); } SEAM(15);
    if (IN(16)) { Gemm g{(const bf16_t*)(ws + WS_H), (const bf16_t*)(ws + WS_WD), M, D, FF}; StaticOrder S; S.init(M, D, c.G, (int)blockIdx.x); EpiF32 E{(float*)(ws + WS_TMP), D};
        gemm_phase<EpiF32, StaticOrder, true, true>(ring, g, S, E); } SEAM(16);
    if (IN(17)) { ph_e10(kargs(), c); }
#undef IN
#undef SEAM
}

#ifndef MK_ONE_LAUNCH
#define MK_ONE_LAUNCH 1
#endif
extern "C" void kernel_launch(void* const* d_in, const int* in_sizes, int n_in, void* d_out, int out_size, void* d_ws, size_t ws_size, hipStream_t stream) {
    static int grid = 0;
    if (grid == 0) {
        if (n_in != N_INPUTS || in_sizes[0] != M * D || out_size != M * D || ws_size < WS_END) { fprintf(stderr, "kernel_launch: unexpected shapes (n_in %d, in0 %d, out %d, ws %zu); nothing launched\n", n_in, n_in > 0 ? in_sizes[0] : -1, out_size, ws_size); grid = -1; return; }
        int dev = 0, cus = 0, per_cu = 0;
        if (hipGetDevice(&dev) != hipSuccess || hipDeviceGetAttribute(&cus, hipDeviceAttributeMultiprocessorCount, dev) != hipSuccess) { grid = -1; return; }
        if (hipFuncSetAttribute((const void*)skel_fwd, hipFuncAttributeMaxDynamicSharedMemorySize, LDS_BYTES) != hipSuccess) { fprintf(stderr, "kernel_launch: hipFuncSetAttribute failed\n"); grid = -1; return; }
        if (hipOccupancyMaxActiveBlocksPerMultiprocessor(&per_cu, (const void*)skel_fwd, NTHR, LDS_BYTES) != hipSuccess || per_cu < 1) fprintf(stderr, "kernel_launch: occupancy query reports %d\n", per_cu);
        (void)hipGetLastError();
        grid = cus;
    }
    if (grid < 0) return;
    (void)hipMemsetAsync((char*)d_ws + WS_CTL, 0, CTL_ZERO_BYTES, stream);
    Args a{};
    for (int i = 0; i < N_INPUTS; ++i) a.in[i] = (const float*)d_in[i];
    a.out = (float*)d_out; a.ws = (unsigned char*)d_ws;
#if MK_ONE_LAUNCH
    a.ph_lo = 0; a.ph_hi = NPH;
    hipLaunchKernelGGL(skel_fwd, dim3(grid), dim3(NTHR), LDS_BYTES, stream, a);
#else
    for (int p = 0; p < NPH; ++p) { a.ph_lo = p; a.ph_hi = p + 1; hipLaunchKernelGGL(skel_fwd, dim3(grid), dim3(NTHR), LDS_BYTES, stream, a); }
#endif
}
```
